# Optimizing an MI355X kernel written in HIP

```python
import math
import jax, jax.numpy as jnp
from jax import lax
import numpy as np

D_MODEL = 1024
BATCH = 8
SEQ = 4096
DEPTH = 2

D_MIX = D_MODEL
N_MIXERS = 4
D_GROUP = D_MIX // N_MIXERS

MLA_HEADS = 4
MLA_Q_RANK = D_MODEL // 4
MLA_KV_RANK = D_MODEL // 8
MLA_NOPE = 64
MLA_ROPE = 32
MLA_V = D_GROUP // MLA_HEADS
ROPE_THETA = 10000.0

CONV_WIDTH = 3
CONV_CH = D_GROUP

POOL_WINDOWS = (2, 4, 8, 16)
POOL_GROUPS = len(POOL_WINDOWS)
POOL_CH = D_GROUP // POOL_GROUPS

SWA_HEADS = 4
SWA_KV_HEADS = 2
SWA_HEAD_DIM = D_GROUP // SWA_HEADS
SWA_WINDOW = 128

BLOCK = 128

D_FF = -(-8 * D_MODEL // (3 * 256)) * 256

RMS_EPS = 1e-6

IN_SPLITS = (MLA_Q_RANK, MLA_KV_RANK, MLA_ROPE,
             CONV_CH, CONV_CH, CONV_CH,
             D_GROUP,
             SWA_HEADS * SWA_HEAD_DIM,
             SWA_KV_HEADS * SWA_HEAD_DIM,
             SWA_KV_HEADS * SWA_HEAD_DIM)
D_IN = sum(IN_SPLITS)

kernel_name = "hybrid_parallel_mla_conv_pool_swa"


def _split_points():
    pts, acc = [], 0
    for w in IN_SPLITS[:-1]:
        acc += w
        pts.append(acc)
    return pts


def _alibi_slopes(n):
    return np.asarray([2.0 ** (-8.0 * (i + 1) / n) for i in range(n)], dtype=np.float32)


def rmsnorm(x, g):
    xf = x.astype(jnp.float32)
    y = xf * lax.rsqrt(jnp.mean(xf * xf, axis=-1, keepdims=True) + RMS_EPS)
    return (y * g.astype(jnp.float32)).astype(x.dtype)


def rope_tables(seq, dim, dtype):
    inv = 1.0 / (ROPE_THETA ** (jnp.arange(0, dim, 2, dtype=jnp.float32) / dim))
    ang = jnp.arange(seq, dtype=jnp.float32)[:, None] * inv[None, :]
    return jnp.cos(ang).astype(dtype), jnp.sin(ang).astype(dtype)


def apply_rope(x, cos, sin):
    x1, x2 = jnp.split(x, 2, axis=-1)
    c = cos[:, None, :]
    s = sin[:, None, :]
    return jnp.concatenate([x1 * c - x2 * s, x1 * s + x2 * c], axis=-1)


def mla_attention(c_q, c_kv, k_r, q_norm_g, kv_norm_g, w_uq, w_ukv, cos, sin):
    b, s, _ = c_q.shape
    dqk = MLA_NOPE + MLA_ROPE
    q = (rmsnorm(c_q, q_norm_g) @ w_uq).reshape(b, s, MLA_HEADS, dqk)
    q_nope, q_rot = q[..., :MLA_NOPE], q[..., MLA_NOPE:]
    q_rot = apply_rope(q_rot, cos, sin)
    kv = (rmsnorm(c_kv, kv_norm_g) @ w_ukv).reshape(b, s, MLA_HEADS, MLA_NOPE + MLA_V)
    k_nope, v = kv[..., :MLA_NOPE], kv[..., MLA_NOPE:]
    k_rot = apply_rope(k_r[:, :, None, :], cos, sin)
    k = jnp.concatenate([k_nope, jnp.broadcast_to(k_rot, (b, s, MLA_HEADS, MLA_ROPE))], axis=-1)
    q = jnp.concatenate([q_nope, q_rot], axis=-1) * (1.0 / math.sqrt(dqk))
    nb = s // BLOCK
    qb = q.reshape(b, nb, BLOCK, MLA_HEADS, dqk).transpose(1, 0, 2, 3, 4)
    key_pos = jnp.arange(s)

    def one_block(args):
        q_blk, i = args
        sc = jnp.einsum('bqhd,bkhd->bhqk', q_blk, k).astype(jnp.float32)
        q_pos = i * BLOCK + jnp.arange(BLOCK)
        causal = key_pos[None, :] <= q_pos[:, None]
        sc = jnp.where(causal[None, None], sc, -jnp.inf)
        p = jax.nn.softmax(sc, axis=-1).astype(v.dtype)
        return jnp.einsum('bhqk,bkhd->bqhd', p, v)

    out = lax.map(one_block, (qb, jnp.arange(nb)))
    return out.transpose(1, 0, 2, 3, 4).reshape(b, s, MLA_HEADS * MLA_V)


def short_gated_conv(gate_b, gate_c, u, conv_w):
    z = gate_c * u
    y = lax.conv_general_dilated(
        z, conv_w[:, None, :].astype(z.dtype), window_strides=(1,),
        padding=[(CONV_WIDTH - 1, 0)], dimension_numbers=('NWC', 'WIO', 'NWC'),
        feature_group_count=CONV_CH)
    return gate_b * y


def multiscale_pool(u, pool_w, pool_scale):
    b, s, _ = u.shape
    uf = u.astype(jnp.float32)
    cs = jnp.cumsum(uf, axis=1)
    pos = jnp.arange(s)
    outs = []
    for g, w in enumerate(POOL_WINDOWS):
        cs_g = cs[:, :, g * POOL_CH:(g + 1) * POOL_CH]
        lag = jnp.pad(cs_g, ((0, 0), (w, 0), (0, 0)))[:, :s]
        count = jnp.minimum(pos + 1, w).astype(jnp.float32)[None, :, None]
        outs.append((cs_g - lag) / count)
    pooled = jnp.stack(outs, axis=2) - uf.reshape(b, s, POOL_GROUPS, POOL_CH)
    mixed = jnp.einsum('bsgc,gcd->bsgd', pooled.astype(u.dtype), pool_w)
    return mixed.reshape(b, s, D_GROUP) * pool_scale


def swa_sink_attention(q, k, v, sinks, slopes):
    b, s, _, hd = q.shape
    grp = SWA_HEADS // SWA_KV_HEADS
    nb = s // BLOCK
    qb = q.reshape(b, nb, BLOCK, SWA_KV_HEADS, grp, hd)
    kb = k.reshape(b, nb, BLOCK, SWA_KV_HEADS, hd)
    vb = v.reshape(b, nb, BLOCK, SWA_KV_HEADS, hd)

    def with_prev(t):
        prev = jnp.pad(t, ((0, 0), (1, 0), (0, 0), (0, 0), (0, 0)))[:, :nb]
        return jnp.concatenate([prev, t], axis=2)

    kk, vv = with_prev(kb), with_prev(vb)
    sc = jnp.einsum('bnqkgd,bnskd->bnkgqs', qb, kk).astype(jnp.float32) * (1.0 / math.sqrt(hd))
    blk = jnp.arange(nb)[:, None] * BLOCK
    q_pos = blk + jnp.arange(BLOCK)[None, :]
    k_pos = blk - BLOCK + jnp.arange(2 * BLOCK)[None, :]
    dist = q_pos[:, :, None] - k_pos[:, None, :]
    valid = (dist >= 0) & (dist < SWA_WINDOW) & (k_pos[:, None, :] >= 0)
    sl = jnp.asarray(slopes).reshape(SWA_KV_HEADS, grp)
    bias = -sl[None, None, :, :, None, None] * dist.astype(jnp.float32)[None, :, None, None, :, :]
    sc = jnp.where(valid[None, :, None, None], sc + bias, -jnp.inf)
    sink = jnp.broadcast_to(
        sinks.astype(jnp.float32).reshape(SWA_KV_HEADS, grp)[None, None, :, :, None, None],
        sc.shape[:-1] + (1,))
    p = jax.nn.softmax(jnp.concatenate([sc, sink], axis=-1), axis=-1)[..., :-1].astype(v.dtype)
    out = jnp.einsum('bnkgqs,bnskd->bnqkgd', p, vv)
    return out.reshape(b, s, SWA_HEADS * hd)


def setup_inputs(seed: int = 0) -> dict:
    key = jax.random.key(seed)
    ks = jax.random.split(key, 17)
    f32 = jnp.float32

    def dense(k, shape, fan_in):
        return jax.random.normal(k, shape, f32) * fan_in ** -0.5

    def gain(k, shape):
        return 1.0 + 0.05 * jax.random.normal(k, shape, f32)

    return {
        "x": jax.random.normal(ks[0], (BATCH, SEQ, D_MODEL), f32),
        "attn_norm": gain(ks[1], (DEPTH, D_MODEL)),
        "w_in": dense(ks[2], (DEPTH, D_MODEL, D_IN), D_MODEL),
        "mla_q_norm": gain(ks[3], (DEPTH, MLA_Q_RANK)),
        "w_uq": dense(ks[4], (DEPTH, MLA_Q_RANK, MLA_HEADS * (MLA_NOPE + MLA_ROPE)), MLA_Q_RANK),
        "mla_kv_norm": gain(ks[5], (DEPTH, MLA_KV_RANK)),
        "w_ukv": dense(ks[6], (DEPTH, MLA_KV_RANK, MLA_HEADS * (MLA_NOPE + MLA_V)), MLA_KV_RANK),
        "conv_w": dense(ks[7], (DEPTH, CONV_WIDTH, CONV_CH), CONV_WIDTH),
        "pool_w": dense(ks[8], (DEPTH, POOL_GROUPS, POOL_CH, POOL_CH), POOL_CH),
        "pool_scale": gain(ks[9], (DEPTH, D_GROUP)),
        "swa_sinks": 0.5 * jax.random.normal(ks[10], (DEPTH, SWA_HEADS), f32),
        "mix_norm": gain(ks[11], (DEPTH, D_MIX)),
        "w_o": dense(ks[12], (DEPTH, D_MIX, D_MODEL), D_MIX),
        "ffn_norm": gain(ks[13], (DEPTH, D_MODEL)),
        "w_gate_up": dense(ks[14], (DEPTH, D_MODEL, 2 * D_FF), D_MODEL),
        "w_down": dense(ks[15], (DEPTH, D_FF, D_MODEL), D_FF),
        "final_norm": gain(ks[16], (D_MODEL,)),
    }


def reference(x, attn_norm, w_in, mla_q_norm, w_uq, mla_kv_norm, w_ukv, conv_w, pool_w,
              pool_scale, swa_sinks, mix_norm, w_o, ffn_norm, w_gate_up, w_down, final_norm):
    b, s, _ = x.shape
    cos, sin = rope_tables(s, MLA_ROPE, x.dtype)
    slopes = _alibi_slopes(SWA_HEADS)
    pts = _split_points()
    for l in range(DEPTH):
        h = rmsnorm(x, attn_norm[l])
        proj = h @ w_in[l]
        (c_q, c_kv, k_r, g_b, g_c, u_conv, u_pool,
         q_sw, k_sw, v_sw) = jnp.split(proj, pts, axis=-1)
        y_a = mla_attention(c_q, c_kv, k_r, mla_q_norm[l], mla_kv_norm[l],
                            w_uq[l], w_ukv[l], cos, sin)
        y_b = short_gated_conv(g_b, g_c, u_conv, conv_w[l])
        y_c = multiscale_pool(u_pool, pool_w[l], pool_scale[l])
        y_d = swa_sink_attention(q_sw.reshape(b, s, SWA_HEADS, SWA_HEAD_DIM),
                                 k_sw.reshape(b, s, SWA_KV_HEADS, SWA_HEAD_DIM),
                                 v_sw.reshape(b, s, SWA_KV_HEADS, SWA_HEAD_DIM),
                                 swa_sinks[l], slopes)
        groups = jnp.stack([y_a, y_b, y_c, y_d], axis=2)
        gf = groups.astype(jnp.float32)
        gf = gf * lax.rsqrt(jnp.mean(gf * gf, axis=-1, keepdims=True) + RMS_EPS)
        mixed = (gf.reshape(b, s, D_MIX) * mix_norm[l].astype(jnp.float32)).astype(x.dtype)
        x = x + mixed @ w_o[l]
        h2 = rmsnorm(x, ffn_norm[l])
        gate, up = jnp.split(h2 @ w_gate_up[l], 2, axis=-1)
        x = x + (jax.nn.silu(gate) * up) @ w_down[l]
    return rmsnorm(x, final_norm)
```

```cpp
#include <hip/hip_runtime.h>
#include <hip/hip_cooperative_groups.h>
#include <cstdio>
#include <cstdint>
namespace cg = cooperative_groups;

#define LAS __attribute__((address_space(3)))
typedef unsigned short bf16_t;
typedef short bf16x8 __attribute__((ext_vector_type(8)));
typedef float f32x4 __attribute__((ext_vector_type(4)));
typedef float f32x16 __attribute__((ext_vector_type(16)));
typedef unsigned u32x4 __attribute__((ext_vector_type(4)));
typedef unsigned u32x2 __attribute__((ext_vector_type(2)));
typedef short s16x4 __attribute__((ext_vector_type(4)));
typedef float f32x2_t __attribute__((ext_vector_type(2)));
typedef __bf16 bf16x2_t __attribute__((ext_vector_type(2)));

constexpr int T_TOK = 32768, SEQ = 4096, DM = 1024, DIN = 1952, DINP = 2048, DFF = 2816;
constexpr int OFF_CQ = 0, OFF_CKV = 256, OFF_KR = 384, OFF_GB = 416, OFF_GC = 672, OFF_UC = 928, OFF_UP = 1184, OFF_QSW = 1440, OFF_KSW = 1696, OFF_VSW = 1824;
constexpr float RMS_EPS = 1e-6f;
constexpr float LOG2E = 1.4426950408889634f;

constexpr size_t MiB = 1u << 20;
constexpr size_t WS_COS = 1 * MiB, WS_SIN = WS_COS + 256 * 1024, WS_RQ = 54 * MiB, WS_RKV = 55 * MiB;
constexpr size_t WS_W = 2 * MiB, W_LAYER = 23 * MiB;
constexpr size_t WO_IN = 0, WO_UQ = 4 * MiB, WO_UKV = WO_UQ + 256 * 1024, WO_O = WO_UKV + 256 * 1024, WO_GU = WO_O + 2 * MiB, WO_D = WO_GU + 11 * MiB;
constexpr size_t WS_SSQA = 48 * MiB, WS_SSQB = 50 * MiB, WS_KR = 52 * MiB;
constexpr size_t WS_XB = 64 * MiB, WS_YB = 128 * MiB, WS_PROJ = 192 * MiB, WS_QM = 320 * MiB, WS_KV = 352 * MiB, WS_ACT = 192 * MiB, WS_END = 384 * MiB;

#ifndef PH_MASK
#define PH_MASK 0xFFFF
#endif
#define PH(n) ((PH_MASK >> (n)) & 1)
constexpr int LDS_BYTES = 147456;

__device__ __forceinline__ unsigned cvtpk(float lo, float hi) { f32x2_t v = {lo, hi}; bf16x2_t b = __builtin_convertvector(v, bf16x2_t); return __builtin_bit_cast(unsigned, b); }
__device__ __forceinline__ float bf_lo(unsigned u) { return __uint_as_float(u << 16); }
__device__ __forceinline__ float bf_hi(unsigned u) { return __uint_as_float(u & 0xffff0000u); }
__device__ __forceinline__ float bf1(bf16_t u) { return __uint_as_float(((unsigned)u) << 16); }
__device__ __forceinline__ f32x4 unpack4(u32x2 v) { return (f32x4){bf_lo(v.x), bf_hi(v.x), bf_lo(v.y), bf_hi(v.y)}; }
__device__ __forceinline__ u32x2 pack4(f32x4 v) { u32x2 r; r.x = cvtpk(v.x, v.y); r.y = cvtpk(v.z, v.w); return r; }
__device__ __forceinline__ int opaque_tid() { int t = threadIdx.x; asm volatile("" : "+v"(t)); return t; }
__device__ __forceinline__ float wave_sum(float v) {
#pragma unroll
    for (int o = 1; o < 64; o <<= 1) v += __shfl_xor(v, o);
    return v;
}

namespace pg8 {
constexpr int BM = 256, BK = 64, HALF = 128, HTB = HALF * BK * 2, STAGE_BYTES = 8 * HTB, NXCD = 8, WGM = 8;
__host__ __device__ __forceinline__ int lds_byte(int r, int c) { const int st = (r >> 4) * 2 + (c >> 5), rr = r & 15, cc = c & 31, ob = rr * 64 + cc * 2; return st * 1024 + (ob ^ (((ob >> 9) & 1) << 5)); }
__host__ __device__ __forceinline__ void stage_rc(int b, int& R, int& C) { const int st = b / 1024, sb = b % 1024, swz = sb ^ (((sb >> 9) & 1) << 5); R = (st >> 1) * 16 + swz / 64; C = (st & 1) * 32 + (swz % 64) / 2; }
__host__ __device__ __forceinline__ int perm32(int rho) { const int n = rho >> 4, i = rho & 15; return 8 * (i >> 2) + 4 * n + (i & 3); }

struct Unit { int pm, pn; };
struct Gemm { const bf16_t* A; const bf16_t* Bt; int M, N, K, lda; };

struct StaticOrder {
    int nM, nN, nwg, G, c;
    __device__ void init(int M, int N, int G_, int c_) { nM = M / BM; nN = N / BM; nwg = nM * nN; G = G_; c = c_; }
    __device__ bool next(int i, Unit& u) const {
        const long L = (long)i * G + c; if (L >= nwg) return false;
        int wgid = (int)L; { const int q = nwg / NXCD, r = nwg % NXCD, xcd = wgid % NXCD, off = wgid / NXCD; wgid = (xcd < r ? xcd * (q + 1) : r * (q + 1) + (xcd - r) * q) + off; }
        const int nig = WGM * nN, gid = wgid / nig, fm = gid * WGM, gsz = (nM - fm) < WGM ? (nM - fm) : WGM;
        u.pm = fm + ((wgid % nig) % gsz); u.pn = (wgid % nig) / gsz; return true;
    }
};

__device__ __forceinline__ float rstd_from_partials(const float* ssq, int row) {
    const f32x4* p = (const f32x4*)(ssq + (size_t)row * 16);
    const f32x4 a = (p[0] + p[1]) + (p[2] + p[3]);
    return rsqrtf(((a.x + a.y) + (a.z + a.w)) * (1.0f / 1024.0f) + RMS_EPS);
}

template <int MODE> struct EpiScaleBf16 {
    static constexpr bool PERM = true, GS = false, RTAB = true;
    __device__ __forceinline__ float tab_value(int row) const {
        if (MODE == 0) return rstd_from_partials(rsv, row);
        const f32x4 p = *(const f32x4*)(rsv + (size_t)row * 4); return rsqrtf(((p.x + p.y) + (p.z + p.w)) * (1.0f / 128.0f) + RMS_EPS);
    }
    bf16_t* O; int ldc; const float* rsv; float* rqp; float* rkvp;
    __device__ __forceinline__ void operator()(const f32x4 (&acc)[2][2][4][2], const Unit& u, int wr, int wc, int fr, int fq, const LAS float* tab) const {
        const int row0 = u.pm * BM + wr * 64 + fr, col0 = u.pn * BM + wc * 32 + 8 * fq;
#pragma unroll
        for (int ai = 0; ai < 2; ++ai)
#pragma unroll
            for (int m = 0; m < 4; ++m) {
                const int row = row0 + ai * HALF + m * 16;
                const float rs = tab ? tab[ai * HALF + wr * 64 + m * 16 + fr] : tab_value(row);
                bf16_t* rowp = O + (size_t)row * ldc + col0;
                float sq0 = 0.f, sq1 = 0.f;
#pragma unroll
                for (int bj = 0; bj < 2; ++bj) {
                    const f32x4 v0 = acc[ai][bj][m][0] * rs, v1 = acc[ai][bj][m][1] * rs;
                    u32x4 w; w.x = cvtpk(v0[0], v0[1]); w.y = cvtpk(v0[2], v0[3]); w.z = cvtpk(v1[0], v1[1]); w.w = cvtpk(v1[2], v1[3]);
                    if (MODE != 0 || col0 + bj * HALF < DIN) *(u32x4*)(rowp + bj * HALF) = w;
                    if (MODE == 0) { const float q = ((v0[0] * v0[0] + v0[1] * v0[1]) + (v0[2] * v0[2] + v0[3] * v0[3])) + ((v1[0] * v1[0] + v1[1] * v1[1]) + (v1[2] * v1[2] + v1[3] * v1[3])); if (bj == 0) sq0 = q; else sq1 = q; }
                }
                if (MODE == 0 && u.pn < 2) {
                    float q = (u.pn == 0) ? sq0 + sq1 : sq0;
                    q += __shfl_xor(q, 16); q += __shfl_xor(q, 32);
                    if (fq == 0) { float* dst = (u.pn == 0) ? rqp : rkvp; dst[(size_t)row * 4 + wc] = q; }
                }
            }
    }
};

struct EpiQRope {
    static constexpr bool PERM = false, GS = false, RTAB = true;
    __device__ __forceinline__ float tab_value(int row) const { const f32x4 pq = *(const f32x4*)(rq + (size_t)row * 4); return rsqrtf(((pq.x + pq.y) + (pq.z + pq.w)) * (1.0f / 256.0f) + RMS_EPS); }
    bf16_t* O; const float* rq; const float* cosT; const float* sinT;
    __device__ __forceinline__ void operator()(const f32x4 (&acc)[2][2][4][2], const Unit& u, int wr, int wc, int fr, int fq, const LAS float* tab) const {
        const int row0 = u.pm * BM + wr * 64 + fr;
#pragma unroll
        for (int ai = 0; ai < 2; ++ai)
#pragma unroll
            for (int m = 0; m < 4; ++m) {
                const int row = row0 + ai * HALF + m * 16;
                const float rs = tab ? tab[ai * HALF + wr * 64 + m * 16 + fr] : tab_value(row);
                const int pos = row & (SEQ - 1);
#pragma unroll
                for (int bj = 0; bj < 2; ++bj) {
                    const int cb = u.pn * BM + bj * HALF + wc * 32;
                    if (cb >= 384) continue;
                    const int g32 = cb >> 5;
                    f32x4 x0 = acc[ai][bj][m][0] * rs, x1 = acc[ai][bj][m][1] * rs;
                    if (g32 == 2 || g32 == 5 || g32 == 8 || g32 == 11) {
                        const f32x4 c4 = *(const f32x4*)(cosT + pos * 16 + 4 * fq), s4 = *(const f32x4*)(sinT + pos * 16 + 4 * fq);
                        const f32x4 o0 = x0 * c4 - x1 * s4, o1 = x0 * s4 + x1 * c4; x0 = o0; x1 = o1;
                    }
                    bf16_t* p = O + (size_t)row * 512 + cb + 4 * fq;
                    *(u32x2*)p = pack4(x0); *(u32x2*)(p + 16) = pack4(x1);
                }
            }
    }
};

template <bool GS_> struct EpiResidT {
    static constexpr bool PERM = true, GS = GS_, RTAB = false;
    bf16_t* xb; float* ssq; const float* ssqh;
    __device__ __forceinline__ void operator()(const f32x4 (&acc)[2][2][4][2], const Unit& u, int wr, int wc, int fr, int fq, const LAS float* tab) const {
        const int row0 = u.pm * BM + wr * 64 + fr, col0 = u.pn * BM + wc * 32 + 8 * fq;
        u32x4 ball[2][4][2];
        if (!GS) {
#pragma unroll
            for (int ai = 0; ai < 2; ++ai)
#pragma unroll
                for (int m = 0; m < 4; ++m)
#pragma unroll
                    for (int bj = 0; bj < 2; ++bj) ball[ai][m][bj] = *(const u32x4*)(xb + (size_t)(row0 + ai * HALF + m * 16) * DM + col0 + bj * HALF);
        }
#pragma unroll
        for (int ai = 0; ai < 2; ++ai) {
            u32x4 bpre[4][2];
#pragma unroll
            for (int m = 0; m < 4; ++m)
#pragma unroll
                for (int bj = 0; bj < 2; ++bj) { if (GS) bpre[m][bj] = *(const u32x4*)(xb + (size_t)(row0 + ai * HALF + m * 16) * DM + col0 + bj * HALF); else bpre[m][bj] = ball[ai][m][bj]; }
#pragma unroll
            for (int m = 0; m < 4; ++m) {
                const int row = row0 + ai * HALF + m * 16; bf16_t* rowp = xb + (size_t)row * DM + col0;
                float ss = 0.f, fs = 1.0f;
                if (GS) fs = tab[4 * (ai * HALF + wr * 64 + m * 16 + fr) + 2];
#pragma unroll
                for (int bj = 0; bj < 2; ++bj) {
                    const u32x4 bv = bpre[m][bj];
                    const f32x4 a0 = GS ? acc[ai][bj][m][0] * fs : acc[ai][bj][m][0], a1 = GS ? acc[ai][bj][m][1] * fs : acc[ai][bj][m][1];
                    const f32x4 o0 = {bf_lo(bv.x) + a0.x, bf_hi(bv.x) + a0.y, bf_lo(bv.y) + a0.z, bf_hi(bv.y) + a0.w};
                    const f32x4 o1 = {bf_lo(bv.z) + a1.x, bf_hi(bv.z) + a1.y, bf_lo(bv.w) + a1.z, bf_hi(bv.w) + a1.w};
                    u32x4 w; w.x = cvtpk(o0.x, o0.y); w.y = cvtpk(o0.z, o0.w); w.z = cvtpk(o1.x, o1.y); w.w = cvtpk(o1.z, o1.w);
                    *(u32x4*)(rowp + bj * HALF) = w;
                    ss += ((o0.x * o0.x + o0.y * o0.y) + (o0.z * o0.z + o0.w * o0.w)) + ((o1.x * o1.x + o1.y * o1.y) + (o1.z * o1.z + o1.w * o1.w));
                }
                ss += __shfl_xor(ss, 16); ss += __shfl_xor(ss, 32);
                if (fq == 0) ssq[(size_t)row * 16 + u.pn * 4 + wc] = ss;
            }
        }
    }
};

struct EpiSwiGLU {
    static constexpr bool PERM = true, GS = false, RTAB = true;
    __device__ __forceinline__ float tab_value(int row) const { return rstd_from_partials(ssq, row); }
    bf16_t* O; const float* ssq;
    __device__ __forceinline__ void operator()(const f32x4 (&acc)[2][2][4][2], const Unit& u, int wr, int wc, int fr, int fq, const LAS float* tab) const {
        const int row0 = u.pm * BM + wr * 64 + fr, col0 = u.pn * HALF + wc * 32 + 8 * fq;
#pragma unroll
        for (int ai = 0; ai < 2; ++ai)
#pragma unroll
            for (int m = 0; m < 4; ++m) {
                const int row = row0 + ai * HALF + m * 16;
                const float rs = tab ? tab[ai * HALF + wr * 64 + m * 16 + fr] : rstd_from_partials(ssq, row);
                float r[8];
#pragma unroll
                for (int n = 0; n < 2; ++n)
#pragma unroll
                    for (int i = 0; i < 4; ++i) {
                        const float g = acc[ai][0][m][n][i] * rs, up = acc[ai][1][m][n][i] * rs;
                        const float sg = __builtin_amdgcn_rcpf(1.0f + __builtin_amdgcn_exp2f(-g * LOG2E));
                        r[n * 4 + i] = g * sg * up;
                    }
                u32x4 w; w.x = cvtpk(r[0], r[1]); w.y = cvtpk(r[2], r[3]); w.z = cvtpk(r[4], r[5]); w.w = cvtpk(r[6], r[7]);
                *(u32x4*)(O + (size_t)row * DFF + col0) = w;
            }
    }
};

template <class Epi, bool ALIGN_EPI>
__device__ __forceinline__ void gemm_phase(LAS unsigned char* lds, const Gemm g, const StaticOrder& S, const Epi& E) {
    const int tid = opaque_tid(), wid = __builtin_amdgcn_readfirstlane(tid >> 6), lane = tid & 63, wr = wid >> 2, wc = wid & 3, fr = lane & 15, fq = lane >> 4;
    int K = g.K; asm volatile("" : "+s"(K));
    const int nt = K / BK, lda = g.lda;
    unsigned voffA[2], voffB[2];
#pragma unroll
    for (int i = 0; i < 2; ++i) { int R, C; stage_rc(tid * 16 + i * 8192, R, C); const int Rb = Epi::PERM ? ((R & ~31) + perm32(R & 31)) : R;
        voffA[i] = (unsigned)(R * lda + C) * 2u; voffB[i] = (unsigned)(Rb * K + C) * 2u; }
    const size_t kstep = (size_t)(BK * 2);
    const size_t hstepA = (size_t)HALF * lda * 2, hstepB = (size_t)HALF * K * 2;
    const size_t tstepA = 2 * hstepA, tstepB = 2 * hstepB;
    const unsigned ldsw = (unsigned)wid * 1024u;
    const int aoff = lds_byte(wr * 64 + fr, fq * 8), boff = lds_byte(wc * 32 + fr, fq * 8);
#define PG8_SA(b, h) (((b) * 2 + (h)) * HTB)
#define PG8_SB(b, h) ((4 + (b) * 2 + (h)) * HTB)
#define PG8_STAGE(bufoff, gbase, voff) do { _Pragma("unroll") for (int _i = 0; _i < 2; ++_i) \
        __builtin_amdgcn_global_load_lds((const unsigned*)((const char*)(gbase) + (voff)[_i]), (LAS unsigned*)(lds + (bufoff) + ldsw + _i * 8192), 16, 0, 0); } while (0)
#define PG8_LDA(dst, b, h) do { _Pragma("unroll") for (int m = 0; m < 4; ++m) _Pragma("unroll") for (int k = 0; k < 2; ++k) dst[m][k] = *(const LAS bf16x8*)(lds + PG8_SA(b, h) + aoff + m * 2048 + k * 1024); } while (0)
#define PG8_LDB(dst, b, h) do { _Pragma("unroll") for (int n = 0; n < 2; ++n) _Pragma("unroll") for (int k = 0; k < 2; ++k) dst[n][k] = *(const LAS bf16x8*)(lds + PG8_SB(b, h) + boff + n * 2048 + k * 1024); } while (0)
#define PG8_MMA(ai, bj, At, Bt) do { __builtin_amdgcn_s_setprio(1); _Pragma("unroll") for (int m = 0; m < 4; ++m) _Pragma("unroll") for (int n = 0; n < 2; ++n) _Pragma("unroll") for (int k = 0; k < 2; ++k) \
        acc[ai][bj][m][n] = __builtin_amdgcn_mfma_f32_16x16x32_bf16(Bt[n][k], At[m][k], acc[ai][bj][m][n], 0, 0, 0); __builtin_amdgcn_s_setprio(0); } while (0)
#define PG8_WAIT_V(n) asm volatile("s_waitcnt vmcnt(" #n ")" ::: "memory")
#define PG8_WAIT_L(n) asm volatile("s_waitcnt lgkmcnt(" #n ")" ::: "memory")
#define PG8_BAR __builtin_amdgcn_s_barrier()
#define PG8_SCHED __builtin_amdgcn_sched_barrier(0)
    Unit cur, nxt; int ui = 0;
    if (!S.next(0, cur)) return;
    f32x4 acc[2][2][4][2];
#pragma unroll
    for (int a = 0; a < 2; ++a)
#pragma unroll
        for (int b = 0; b < 2; ++b)
#pragma unroll
            for (int m = 0; m < 4; ++m)
#pragma unroll
                for (int n = 0; n < 2; ++n) acc[a][b][m][n] = (f32x4){0.f, 0.f, 0.f, 0.f};
    bf16x8 At[4][2], B0[2][2], B1[2][2];
    const char* cA = (const char*)g.A + (size_t)cur.pm * tstepA; const char* cB = (const char*)g.Bt + (size_t)cur.pn * tstepB;
    constexpr int GS_MAX = 3;
    LAS f32x4* gtab = (LAS f32x4*)(lds + STAGE_BYTES + 1024);
    if constexpr (Epi::GS) { Unit tu_; for (int i_ = 0; i_ < GS_MAX && S.next(i_, tu_); ++i_) { if (tid < 256) { const float* sp_ = E.ssqh + (size_t)(tu_.pm * BM + tid) * 8; const f32x4 pa_ = *(const f32x4*)sp_, pd_ = *(const f32x4*)(sp_ + 4);
        const float ma_ = ((pa_.x + pa_.y) + (pa_.z + pa_.w)) * (1.0f / 256.0f) + RMS_EPS, md_ = ((pd_.x + pd_.y) + (pd_.z + pd_.w)) * (1.0f / 256.0f) + RMS_EPS;
        gtab[i_ * 256 + tid] = (f32x4){rsqrtf(ma_), sqrtf(md_), rsqrtf(md_), 0.f}; } } }
#define PG8_GS_SCALE(sel_) do { _Pragma("unroll") for (int a_ = 0; a_ < 2; ++a_) _Pragma("unroll") for (int m_ = 0; m_ < 4; ++m_) { const int rl_ = a_ * HALF + wr * 64 + m_ * 16 + fr; float fa_, fd_; \
        { const f32x4 f4_ = gtab[ui * 256 + rl_]; fa_ = f4_.x; fd_ = f4_.y; }     \
        const float f_ = (sel_) == 0 ? 1.0f : ((sel_) == 1 ? fa_ : fd_); \
        _Pragma("unroll") for (int b_ = 0; b_ < 2; ++b_) _Pragma("unroll") for (int n_ = 0; n_ < 2; ++n_) acc[a_][b_][m_][n_] = acc[a_][b_][m_][n_] * f_; __builtin_amdgcn_sched_barrier(0); } } while (0)
    constexpr int RT_MAX = 11;
    LAS float* rtab = (LAS float*)(lds + STAGE_BYTES + 4096);
    if constexpr (Epi::RTAB) { Unit tu_; for (int i_ = 0; i_ < RT_MAX && S.next(i_, tu_); ++i_) { if (tid < 256) rtab[i_ * 256 + tid] = E.tab_value(tu_.pm * BM + tid); } }
    PG8_STAGE(PG8_SB(0, 0), cB, voffB); PG8_STAGE(PG8_SB(0, 1), cB + hstepB, voffB); PG8_STAGE(PG8_SA(0, 0), cA, voffA); PG8_STAGE(PG8_SA(0, 1), cA + hstepA, voffA);
    if (wr == 1) PG8_BAR;
    PG8_WAIT_V(2); PG8_BAR;
    PG8_STAGE(PG8_SB(1, 0), cB + kstep, voffB); PG8_STAGE(PG8_SA(1, 0), cA + kstep, voffA); PG8_STAGE(PG8_SB(1, 1), cB + hstepB + kstep, voffB);
    PG8_WAIT_V(6); PG8_BAR;
    for (;;) {
        const bool has_next = S.next(ui + 1, nxt);
        const char* nA = has_next ? (const char*)g.A + (size_t)nxt.pm * tstepA : cA; const char* nB = has_next ? (const char*)g.Bt + (size_t)nxt.pn * tstepB : cB;
#pragma unroll 1
        for (int seg = 0; seg < (Epi::GS ? 3 : 1); ++seg) {
        const int tb = Epi::GS ? (seg == 0 ? 0 : (seg == 1 ? 4 : 12)) : 0, te = Epi::GS ? (seg == 0 ? 4 : (seg == 1 ? 12 : nt)) : nt;
        if constexpr (Epi::GS) { PG8_GS_SCALE(seg); }
#pragma unroll 1
        for (int t = tb; t < te; t += 2) {
            const bool last = (t == nt - 2);
            const char* a1 = cA + (size_t)(t + 1) * kstep;
            const char* a2 = last ? nA : cA + (size_t)(t + 2) * kstep; const char* b2 = last ? nB : cB + (size_t)(t + 2) * kstep;
            const char* a3 = a2 + kstep; const char* b3 = b2 + kstep;
            PG8_LDB(B0, 0, 0); PG8_LDB(B1, 0, 1); PG8_SCHED; PG8_LDA(At, 0, 0); PG8_STAGE(PG8_SA(1, 1), a1 + hstepA, voffA);
            PG8_WAIT_V(8); PG8_WAIT_L(0); PG8_BAR; PG8_MMA(0, 0, At, B0); PG8_MMA(0, 1, At, B1); PG8_BAR; PG8_SCHED;
            PG8_LDA(At, 0, 1); PG8_STAGE(PG8_SB(0, 0), b2, voffB); PG8_STAGE(PG8_SB(0, 1), b2 + hstepB, voffB); PG8_STAGE(PG8_SA(0, 0), a2, voffA);
            PG8_WAIT_V(8); PG8_WAIT_L(0); PG8_BAR; PG8_MMA(1, 0, At, B0); PG8_MMA(1, 1, At, B1); PG8_BAR; PG8_SCHED;
            PG8_LDB(B0, 1, 0); PG8_LDB(B1, 1, 1); PG8_SCHED; PG8_LDA(At, 1, 0); PG8_STAGE(PG8_SA(0, 1), a2 + hstepA, voffA);
            PG8_WAIT_V(8); PG8_WAIT_L(0); PG8_BAR; PG8_MMA(0, 0, At, B0); PG8_MMA(0, 1, At, B1); PG8_BAR; PG8_SCHED;
            PG8_LDA(At, 1, 1); PG8_STAGE(PG8_SB(1, 0), b3, voffB); PG8_STAGE(PG8_SB(1, 1), b3 + hstepB, voffB); PG8_STAGE(PG8_SA(1, 0), a3, voffA);
            PG8_WAIT_V(8); PG8_WAIT_L(0); PG8_BAR; PG8_MMA(1, 0, At, B0); PG8_MMA(1, 1, At, B1); PG8_BAR; PG8_SCHED;
        }
        }
        if constexpr (ALIGN_EPI) { if (wr == 0) PG8_BAR; }
        E(acc, cur, wr, wc, fr, fq, (Epi::RTAB && ui < RT_MAX) ? (const LAS float*)(rtab + ui * 256) : (Epi::GS ? (const LAS float*)(gtab + ui * 256) : (const LAS float*)nullptr));
        if (!has_next) break;
#pragma unroll
        for (int a = 0; a < 2; ++a)
#pragma unroll
            for (int b = 0; b < 2; ++b)
#pragma unroll
                for (int m = 0; m < 4; ++m)
#pragma unroll
                    for (int n = 0; n < 2; ++n) acc[a][b][m][n] = (f32x4){0.f, 0.f, 0.f, 0.f};
        cur = nxt; cA = nA; cB = nB; ++ui;
        if constexpr (ALIGN_EPI) { if (wr == 1) PG8_BAR; }
    }
    PG8_WAIT_V(0);
    if constexpr (!ALIGN_EPI) { if (wr == 0) PG8_BAR; }
    PG8_BAR;
#undef PG8_GS_SCALE
#undef PG8_SA
#undef PG8_SB
#undef PG8_STAGE
#undef PG8_LDA
#undef PG8_LDB
#undef PG8_MMA
#undef PG8_WAIT_V
#undef PG8_WAIT_L
#undef PG8_BAR
#undef PG8_SCHED
}
}

namespace att {
constexpr int KP = 104, VP = 96;
constexpr int KBYTES = 64 * KP * 2, VBYTES = 64 * VP * 2, BUFB = KBYTES + VBYTES;
__device__ __forceinline__ int crow(int r, int hi) { return (r & 3) + 8 * (r >> 2) + 4 * hi; }

template <bool SWA>
__device__ __forceinline__ void unit(LAS unsigned char* lds, const bf16_t* Qp, int qpitch, const bf16_t* K1, int k1pitch, const bf16_t* K2,
                                     const bf16_t* Vp, int vpitch, bf16_t* Yp, float* ssqh, int q0, float cscale, float slope2, float sink2) {
    constexpr int DQK = SWA ? 64 : 96, ND = DQK / 16;
    const int tid = opaque_tid(), lane = tid & 63, wid = __builtin_amdgcn_readfirstlane(tid >> 6), r32 = lane & 31, hi = lane >> 5;
    const int qw = q0 + wid * 32, qrow = qw + r32;
    if (wid < 4) __builtin_amdgcn_s_setprio(2); else __builtin_amdgcn_s_setprio(0);
    bf16x8 qf[ND];
#pragma unroll
    for (int d0 = 0; d0 < ND; ++d0) {
        const u32x4 v = *(const u32x4*)(Qp + (size_t)qrow * qpitch + 16 * d0 + 8 * hi);
        u32x4 w; w.x = cvtpk(bf_lo(v.x) * cscale, bf_hi(v.x) * cscale); w.y = cvtpk(bf_lo(v.y) * cscale, bf_hi(v.y) * cscale);
        w.z = cvtpk(bf_lo(v.z) * cscale, bf_hi(v.z) * cscale); w.w = cvtpk(bf_lo(v.w) * cscale, bf_hi(v.w) * cscale);
        qf[d0] = __builtin_bit_cast(bf16x8, w);
    }
    const int t_lo = SWA ? (q0 >= 128 ? (q0 - 128) / 64 : 0) : 0, t_hi = (q0 + 256) / 64;
    constexpr float THR = 8.0f;
    float mrun = SWA ? sink2 : 0.f, lrun = (SWA && hi == 0) ? 1.f : 0.f;
    bool fresh = !SWA;
    f32x16 negm;
#pragma unroll
    for (int r = 0; r < 16; ++r) negm[r] = -mrun;
    f32x16 o0, o1;
#pragma unroll
    for (int r = 0; r < 16; ++r) { o0[r] = 0.f; o1[r] = 0.f; }
    const int k1key = tid >> 3, k1ch = tid & 7, k2key = (tid >> 2) & 63, k2ch = tid & 3;
    const bf16_t* k1src = K1 + (size_t)k1key * k1pitch + k1ch * 8;
    const bf16_t* k2src = SWA ? K1 : (K2 + (size_t)k2key * 32 + k2ch * 8);
    const bf16_t* vsrc = Vp + (size_t)k1key * vpitch + k1ch * 8;
    u32x4 rk1[2], rk2[2], rv[2];
#define ATT_ISSUE(t) do { _Pragma("unroll") for (int s_ = 0; s_ < 2; ++s_) { rk1[s_] = *(const u32x4*)(k1src + (size_t)((t) + s_) * 64 * k1pitch); \
        if (!SWA && tid < 256) rk2[s_] = *(const u32x4*)(k2src + (size_t)((t) + s_) * 64 * 32); \
        rv[s_] = *(const u32x4*)(vsrc + (size_t)((t) + s_) * 64 * vpitch); } } while (0)
    ATT_ISSUE(t_lo);
    for (int tp = t_lo; tp < t_hi; tp += 2) {
        LAS unsigned char* kbp = lds + (((tp - t_lo) >> 1) & 1) * (2 * BUFB);
#pragma unroll
        for (int s_ = 0; s_ < 2; ++s_) {
            LAS unsigned char* kb = kbp + s_ * BUFB;
            LAS unsigned char* vb = kb + KBYTES;
            *(LAS u32x4*)(kb + k1key * (KP * 2) + k1ch * 16) = rk1[s_];
            if (!SWA && tid < 256) *(LAS u32x4*)(kb + k2key * (KP * 2) + 128 + k2ch * 16) = rk2[s_];
            *(LAS u32x4*)(vb + k1key * (VP * 2) + k1ch * 16) = rv[s_];
        }
        __syncthreads();
        if (tp + 2 < t_hi) ATT_ISSUE(tp + 2);
        {
        const int kt0 = 64 * tp;
        bool skipA = kt0 > qw + 31, skipB = kt0 + 64 > qw + 31;
        if (SWA) { skipA = skipA || (kt0 + 63 < qw - 127); skipB = skipB || (kt0 + 127 < qw - 127); }
        if (!(skipA && skipB)) {
            f32x16 p[2][2];
#pragma unroll
            for (int s_ = 0; s_ < 2; ++s_) {
                const LAS unsigned char* kb = kbp + s_ * BUFB;
#pragma unroll
                for (int d0 = 0; d0 < ND; ++d0) {
                    const bf16x8 a0 = *(const LAS bf16x8*)(kb + r32 * (KP * 2) + d0 * 32 + hi * 16);
                    const bf16x8 a1 = *(const LAS bf16x8*)(kb + (32 + r32) * (KP * 2) + d0 * 32 + hi * 16);
                    p[s_][0] = __builtin_amdgcn_mfma_f32_32x32x16_bf16(a0, qf[d0], d0 == 0 ? negm : p[s_][0], 0, 0, 0);
                    p[s_][1] = __builtin_amdgcn_mfma_f32_32x32x16_bf16(a1, qf[d0], d0 == 0 ? negm : p[s_][1], 0, 0, 0);
                }
            }
            const bool need_mask = SWA || (kt0 + 127 > qw);
            if (need_mask) {
#pragma unroll
                for (int s_ = 0; s_ < 2; ++s_)
#pragma unroll
                    for (int r = 0; r < 16; ++r) {
                        const int d0_ = qrow - (kt0 + 64 * s_ + crow(r, hi)), d1_ = d0_ - 32;
                        float s0 = p[s_][0][r], s1 = p[s_][1][r];
                        bool v0 = d0_ >= 0, v1 = d1_ >= 0;
                        if (SWA) { s0 -= slope2 * (float)d0_; s1 -= slope2 * (float)d1_; v0 = v0 && d0_ < 128; v1 = v1 && d1_ < 128; }
                        p[s_][0][r] = v0 ? s0 : -1e30f; p[s_][1][r] = v1 ? s1 : -1e30f;
                    }
            }
            float mx;
            { float a = -1e30f, b = -1e30f;
#pragma unroll
              for (int r = 0; r < 16; r += 2) { a = fmaxf(fmaxf(a, p[0][0][r]), p[0][0][r + 1]); b = fmaxf(fmaxf(b, p[0][1][r]), p[0][1][r + 1]); a = fmaxf(fmaxf(a, p[1][0][r]), p[1][0][r + 1]); b = fmaxf(fmaxf(b, p[1][1][r]), p[1][1][r + 1]); }
              mx = fmaxf(a, b);
              auto rr = __builtin_amdgcn_permlane32_swap(__float_as_uint(mx), __float_as_uint(mx), false, false);
              mx = fmaxf(__uint_as_float(rr[0]), __uint_as_float(rr[1])); }
            const bool resc = fresh || (mx > THR);
            if (__any(resc)) {
                const float delta = fresh ? mx : (mx > THR ? mx : 0.f);
                mrun += delta;
                const float alpha = __builtin_amdgcn_exp2f(-delta);
                lrun *= alpha;
#pragma unroll
                for (int r = 0; r < 16; ++r) { p[0][0][r] -= delta; p[0][1][r] -= delta; p[1][0][r] -= delta; p[1][1][r] -= delta; o0[r] *= alpha; o1[r] *= alpha; negm[r] = -mrun; }
                fresh = false;
            }
            float ls0 = 0.f, ls1 = 0.f;
#pragma unroll
            for (int s_ = 0; s_ < 2; ++s_)
#pragma unroll
                for (int r = 0; r < 16; ++r) { p[s_][0][r] = __builtin_amdgcn_exp2f(p[s_][0][r]); p[s_][1][r] = __builtin_amdgcn_exp2f(p[s_][1][r]); ls0 += p[s_][0][r]; ls1 += p[s_][1][r]; }
            lrun += ls0 + ls1;
#pragma unroll
            for (int s_ = 0; s_ < 2; ++s_) {
                const LAS unsigned char* vb = kbp + s_ * BUFB + KBYTES;
#pragma unroll
                for (int c = 0; c < 4; ++c) {
                    const f32x16& ps = p[s_][c >> 1]; const int b8 = 8 * (c & 1);
                    u32x4 w; w.x = cvtpk(ps[b8 + 0], ps[b8 + 1]); w.y = cvtpk(ps[b8 + 2], ps[b8 + 3]); w.z = cvtpk(ps[b8 + 4], ps[b8 + 5]); w.w = cvtpk(ps[b8 + 6], ps[b8 + 7]);
                    const bf16x8 pb = __builtin_bit_cast(bf16x8, w);
                    const LAS unsigned char* va = vb + (16 * c + 4 * hi + ((lane & 15) >> 2)) * (VP * 2) + (16 * ((lane >> 4) & 1) + 4 * (lane & 3)) * 2;
                    const s16x4 x0 = __builtin_amdgcn_ds_read_tr16_b64_v4i16((LAS s16x4*)(va)), x1 = __builtin_amdgcn_ds_read_tr16_b64_v4i16((LAS s16x4*)(va + 8 * VP * 2));
                    const s16x4 y0 = __builtin_amdgcn_ds_read_tr16_b64_v4i16((LAS s16x4*)(va + 64)), y1 = __builtin_amdgcn_ds_read_tr16_b64_v4i16((LAS s16x4*)(va + 8 * VP * 2 + 64));
                    const bf16x8 fa = {x0[0], x0[1], x0[2], x0[3], x1[0], x1[1], x1[2], x1[3]}, fb = {y0[0], y0[1], y0[2], y0[3], y1[0], y1[1], y1[2], y1[3]};
                    o0 = __builtin_amdgcn_mfma_f32_32x32x16_bf16(fa, pb, o0, 0, 0, 0);
                    o1 = __builtin_amdgcn_mfma_f32_32x32x16_bf16(fb, pb, o1, 0, 0, 0);
                }
            }
        }
        }
    }
#undef ATT_ISSUE
    const float ltot = lrun + __shfl_xor(lrun, 32);
    const float inv = 1.0f / ltot;
    bf16_t* yrow = Yp + (size_t)qrow * DM;
    float ssy = 0.f;
#pragma unroll
    for (int rg = 0; rg < 4; ++rg) {
        const f32x4 a = {o0[4 * rg] * inv, o0[4 * rg + 1] * inv, o0[4 * rg + 2] * inv, o0[4 * rg + 3] * inv};
        const f32x4 b = {o1[4 * rg] * inv, o1[4 * rg + 1] * inv, o1[4 * rg + 2] * inv, o1[4 * rg + 3] * inv};
        *(u32x2*)(yrow + 8 * rg + 4 * hi) = pack4(a);
        *(u32x2*)(yrow + 32 + 8 * rg + 4 * hi) = pack4(b);
        ssy += ((a.x * a.x + a.y * a.y) + (a.z * a.z + a.w * a.w)) + ((b.x * b.x + b.y * b.y) + (b.z * b.z + b.w * b.w));
    }
    ssy += __shfl_xor(ssy, 32);
    if (hi == 0) ssqh[(size_t)qrow * 8] = ssy;
    __builtin_amdgcn_s_setprio(0);
    __syncthreads();
}
}

#define XB_TMO      128
#define XB_XCNT(j)  (256  + 64 * (j))
#define XB_XSUB(j)  (1280 + 64 * (j))
#define XB_XGEN(j)  (2304 + 64 * (j))
#define XB_TOP      3328
#define XB_TOPGEN   3392
#define XCD_BAR_WORDS 3456
#define XB_SPIN_CAP (1u << 18)
__device__ __forceinline__ unsigned xb_ld(unsigned* p)              { return __hip_atomic_load(p, __ATOMIC_RELAXED, __HIP_MEMORY_SCOPE_AGENT); }
__device__ __forceinline__ unsigned xb_add(unsigned* p, unsigned v) { return __hip_atomic_fetch_add(p, v, __ATOMIC_RELAXED, __HIP_MEMORY_SCOPE_AGENT); }
__device__ __forceinline__ unsigned xb_xcc_id() { return (unsigned)__builtin_amdgcn_s_getreg((3 << 11) | 20) & 0xFu; }
#define XB_SPIN(cond, bar) do { unsigned _sp = 0; while (cond) { __builtin_amdgcn_s_sleep(1); \
    if ((++_sp & 255u) == 0u) { if (xb_ld(&(bar)[XB_TMO])) break; if (_sp > XB_SPIN_CAP) { atomicAdd(&(bar)[XB_TMO], 1u); break; } } } } while (0)
struct XcdBarrier { unsigned* bar; unsigned x; volatile LAS unsigned* st; };
__device__ __forceinline__ XcdBarrier xcd_barrier_post(unsigned* bar, volatile LAS unsigned* st) {
    XcdBarrier b; b.bar = bar; b.x = xb_xcc_id(); b.st = st;
    if (threadIdx.x == 0) (void)xb_add(&bar[XB_XCNT(b.x)], 1u);
    return b;
}
__device__ __forceinline__ void xcd_barrier_complete(unsigned* bar, unsigned x, unsigned& nloc, unsigned& nx) {
    const unsigned G = gridDim.x * gridDim.y * gridDim.z;
    unsigned sum, cnt, mine, sp = 0u;
    for (;;) {
        sum = 0u; cnt = 0u; mine = 0u;
#pragma unroll
        for (unsigned j = 0; j < 16; ++j) { const unsigned c = xb_ld(&bar[XB_XCNT(j)]); sum += c; cnt += (c > 0u) ? 1u : 0u; mine = (j == x) ? c : mine; }
        if (sum == G) break;
        __builtin_amdgcn_s_sleep(1);
        if ((++sp & 255u) == 0u) { if (xb_ld(&bar[XB_TMO])) break; if (sp > XB_SPIN_CAP) { atomicAdd(&bar[XB_TMO], 1u); break; } }
    }
    nloc = mine > 0u ? mine : 1u; nx = cnt > 0u ? cnt : 1u;
}
__device__ __forceinline__ void xcd_barrier(const XcdBarrier& b) {
    asm volatile("s_waitcnt vmcnt(0)" ::: "memory");
    __syncthreads();
    if (threadIdx.x == 0) {
        unsigned* bar = b.bar;
        __builtin_amdgcn_s_waitcnt(0);
        unsigned nloc = b.st[0], nx = b.st[1];
        if (nloc == 0u) { xcd_barrier_complete(bar, b.x, nloc, nx); b.st[0] = nloc; b.st[1] = nx; }
        const unsigned old = xb_add(&bar[XB_XSUB(b.x)], 1u);
        const unsigned gen = old / nloc;
        if (old + 1u == (gen + 1u) * nloc) {
            __builtin_amdgcn_fence(__ATOMIC_RELEASE, "agent");
            asm volatile("s_waitcnt vmcnt(0)" ::: "memory");
            const unsigned og = xb_add(&bar[XB_TOP], 1u);
            const unsigned tg = og / nx;
            if (og + 1u == (tg + 1u) * nx) xb_add(&bar[XB_TOPGEN], 1u);
            else XB_SPIN(xb_ld(&bar[XB_TOPGEN]) == tg, bar);
            __builtin_amdgcn_fence(__ATOMIC_ACQUIRE, "agent");
            xb_add(&bar[XB_XGEN(b.x)], 1u);
            asm volatile("s_waitcnt vmcnt(0)" ::: "memory");
        } else {
            XB_SPIN(xb_ld(&bar[XB_XGEN(b.x)]) == gen, bar);
            __builtin_amdgcn_fence(__ATOMIC_ACQUIRE, "agent");
            asm volatile("s_waitcnt vmcnt(0)" ::: "memory");
        }
    }
    __syncthreads();
}

struct Args { const float* in[17]; float* out; unsigned char* ws; };
enum { I_X = 0, I_ATTN_NORM, I_W_IN, I_MLA_Q_NORM, I_W_UQ, I_MLA_KV_NORM, I_W_UKV, I_CONV_W, I_POOL_W, I_POOL_SCALE, I_SWA_SINKS, I_MIX_NORM, I_W_O, I_FFN_NORM, I_W_GATE_UP, I_W_DOWN, I_FINAL_NORM };

__device__ __forceinline__ void tr_item(const float* W, int K, int N, const float* gain, bf16_t* WT, int item, int mode, LAS float* scr, int lane) {
    const int nblk = N / 32, kb = item / nblk, nb = item % nblk, k0 = 64 * kb, n0 = 32 * nb;
    int drow0 = n0;
    if (mode == 1) drow0 = (n0 < DFF) ? ((n0 >> 7) * 256 + (n0 & 127)) : (((n0 - DFF) >> 7) * 256 + 128 + ((n0 - DFF) & 127));
    {
        f32x4 v[8];
#pragma unroll
        for (int i = 0; i < 8; ++i) v[i] = __builtin_nontemporal_load((const f32x4*)(W + (size_t)(k0 + 8 * i + (lane >> 3)) * N + n0 + 4 * (lane & 7)));
#pragma unroll
        for (int i = 0; i < 8; ++i) { LAS float* d = scr + (8 * i + (lane >> 3)) * 33 + 4 * (lane & 7); d[0] = v[i].x; d[1] = v[i].y; d[2] = v[i].z; d[3] = v[i].w; }
    }
    asm volatile("s_waitcnt lgkmcnt(0)" ::: "memory");
    const int c = lane & 7;
    f32x4 g0 = {1.f, 1.f, 1.f, 1.f}, g1 = g0;
    if (gain) { g0 = *(const f32x4*)(gain + k0 + 8 * c); g1 = *(const f32x4*)(gain + k0 + 8 * c + 4); }
#pragma unroll
    for (int j = 0; j < 4; ++j) { const int n = (lane >> 3) + 8 * j; const LAS float* sp = scr + (8 * c) * 33 + n;
        u32x4 o; o.x = cvtpk(sp[0 * 33] * g0.x, sp[1 * 33] * g0.y); o.y = cvtpk(sp[2 * 33] * g0.z, sp[3 * 33] * g0.w); o.z = cvtpk(sp[4 * 33] * g1.x, sp[5 * 33] * g1.y); o.w = cvtpk(sp[6 * 33] * g1.z, sp[7 * 33] * g1.w);
        *(u32x4*)(WT + (size_t)(drow0 + n) * K + k0 + 8 * c) = o; }
    asm volatile("s_waitcnt lgkmcnt(0)" ::: "memory");
}

__global__ void __launch_bounds__(512, 2) fwd_kernel(Args a) {
    extern __shared__ __attribute__((aligned(16))) unsigned char lds_raw[];
    LAS unsigned char* lds = (LAS unsigned char*)lds_raw;
    cg::grid_group grid = cg::this_grid();
    const int G = gridDim.x, bx = blockIdx.x;
    const int vcu = (G % 8 == 0) ? (bx % 8) * (G / 8) + bx / 8 : bx;
    const int NGW = G * 8;
#define PHASE_IDS const int tid = opaque_tid(), lane = tid & 63, wave = __builtin_amdgcn_readfirstlane(tid >> 6), gw = bx * 8 + wave; (void)tid; (void)lane; (void)gw
    unsigned char* ws = a.ws;
    float* cosT = (float*)(ws + WS_COS); float* sinT = (float*)(ws + WS_SIN);
    float* RQ = (float*)(ws + WS_RQ); float* RKV = (float*)(ws + WS_RKV);
    float* SSQA = (float*)(ws + WS_SSQA); float* SSQB = (float*)(ws + WS_SSQB); float* SSQH = (float*)(ws + 56 * MiB);
    bf16_t* KR = (bf16_t*)(ws + WS_KR); bf16_t* XB = (bf16_t*)(ws + WS_XB); bf16_t* YB = (bf16_t*)(ws + WS_YB);
    bf16_t* PROJ = (bf16_t*)(ws + WS_PROJ); bf16_t* QM = (bf16_t*)(ws + WS_QM); bf16_t* KV = (bf16_t*)(ws + WS_KV); bf16_t* ACT = (bf16_t*)(ws + WS_ACT);
    float* OUT = a.out;
    unsigned* BARW = (unsigned*)ws;
    volatile LAS unsigned* BST = (volatile LAS unsigned*)(lds + 131072 + 64);
    if (threadIdx.x < 2) BST[threadIdx.x] = 0u;
    {
        constexpr unsigned XB_MAGIC = 0x600DF1A6u;
        if (bx == 0) {
            const int t = threadIdx.x;
            if (t < 51) { const int w = t < 16 ? XB_XCNT(t) : t < 32 ? XB_XSUB(t - 16) : t < 48 ? XB_XGEN(t - 32) : t == 48 ? XB_TMO : t == 49 ? XB_TOP : XB_TOPGEN;
                __hip_atomic_store(&BARW[w], 0u, __ATOMIC_RELAXED, __HIP_MEMORY_SCOPE_AGENT); }
            asm volatile("s_waitcnt vmcnt(0)" ::: "memory");
            __syncthreads();
            if (t == 0) { __hip_atomic_store(&BARW[64], XB_MAGIC, __ATOMIC_RELAXED, __HIP_MEMORY_SCOPE_AGENT); asm volatile("s_waitcnt vmcnt(0)" ::: "memory"); }
        }
        __syncthreads();
    }
#define GRID_BAR() do { XcdBarrier xb_; xb_.bar = (unsigned*)a.ws; xb_.x = xb_xcc_id(); xb_.st = (volatile LAS unsigned*)(lds + 131072 + 64); xcd_barrier(xb_); } while (0)

    if (PH(0)) {
        PHASE_IDS;
        LAS float* scr = (LAS float*)(lds + wave * 16384);
        constexpr int I_IN = 16 * 61, I_UQ = 4 * 12, I_UKV = 2 * 16, I_O = 16 * 32, I_GU = 16 * 176, I_D = 44 * 32, I_L = I_IN + I_UQ + I_UKV + I_O + I_GU + I_D;
        for (int it = gw; it < 2 * I_L; it += NGW) {
            const int l = it / I_L; int r = it % I_L;
            unsigned char* wl = ws + WS_W + (size_t)l * W_LAYER;
            if (r < I_IN) { tr_item(a.in[I_W_IN] + (size_t)l * DM * DIN, DM, DIN, a.in[I_ATTN_NORM] + l * DM, (bf16_t*)(wl + WO_IN), r, 0, scr, lane); continue; } r -= I_IN;
            if (r < I_UQ) { tr_item(a.in[I_W_UQ] + (size_t)l * 256 * 384, 256, 384, a.in[I_MLA_Q_NORM] + l * 256, (bf16_t*)(wl + WO_UQ), r, 0, scr, lane); continue; } r -= I_UQ;
            if (r < I_UKV) { tr_item(a.in[I_W_UKV] + (size_t)l * 128 * 512, 128, 512, a.in[I_MLA_KV_NORM] + l * 128, (bf16_t*)(wl + WO_UKV), r, 0, scr, lane); continue; } r -= I_UKV;
            if (r < I_O) { tr_item(a.in[I_W_O] + (size_t)l * DM * DM, DM, DM, a.in[I_MIX_NORM] + l * DM, (bf16_t*)(wl + WO_O), r, 0, scr, lane); continue; } r -= I_O;
            if (r < I_GU) { tr_item(a.in[I_W_GATE_UP] + (size_t)l * DM * 2 * DFF, DM, 2 * DFF, a.in[I_FFN_NORM] + l * DM, (bf16_t*)(wl + WO_GU), r, 1, scr, lane); continue; } r -= I_GU;
            tr_item(a.in[I_W_DOWN] + (size_t)l * DFF * DM, DFF, DM, nullptr, (bf16_t*)(wl + WO_D), r, 0, scr, lane);
        }
        {
            const int gt = bx * 512 + tid, NT = G * 512;
            const u32x4 z = {0u, 0u, 0u, 0u};
            for (int l = 0; l < 2; ++l) {
                unsigned char* wl = ws + WS_W + (size_t)l * W_LAYER;
                u32x4* p1 = (u32x4*)(wl + WO_IN + (size_t)DIN * DM * 2);
                for (int i = gt; i < (DINP - DIN) * DM * 2 / 16; i += NT) p1[i] = z;
                u32x4* p2 = (u32x4*)(wl + WO_UQ + (size_t)384 * 256 * 2);
                for (int i = gt; i < 128 * 256 * 2 / 16; i += NT) p2[i] = z;
            }
            for (int i = gt; i < 2 * 16384; i += NT) { const int l = i >> 14, idx = i & 16383, g = idx >> 12, c = (idx >> 6) & 63, d = idx & 63;
                ((bf16_t*)(ws + 57 * MiB))[(size_t)l * 18432 + (g * 64 + d) * 72 + c] = (bf16_t)(cvtpk(a.in[I_POOL_W][i], 0.f) & 0xffffu); }
            for (int i = gt; i < SEQ * 16; i += NT) {
                const int pos = i >> 4, j = i & 15;
                const float inv = 1.0f / powf(10000.0f, (float)(2 * j) / 32.0f);
                const float ang = (float)pos * inv;
                cosT[i] = cosf(ang); sinT[i] = sinf(ang);
            }
        }
        const float* X = a.in[I_X];
        for (int r16 = (vcu * 8 + wave) * 16; r16 < T_TOK; r16 += NGW * 16)
        for (int r4 = r16; r4 < r16 + 16; r4 += 8) {
            f32x4 v[8][4];
#pragma unroll
            for (int k = 0; k < 8; ++k)
#pragma unroll
                for (int j = 0; j < 4; ++j) v[k][j] = __builtin_nontemporal_load((const f32x4*)(X + (size_t)(r4 + k) * DM) + lane + 64 * j);
            float ss[8];
#pragma unroll
            for (int k = 0; k < 8; ++k) { ss[k] = 0.f;
#pragma unroll
                for (int j = 0; j < 4; ++j) { const f32x4 w = v[k][j]; ss[k] += (w.x * w.x + w.y * w.y) + (w.z * w.z + w.w * w.w); ((u32x2*)(XB + (size_t)(r4 + k) * DM) + lane)[64 * j] = pack4(w); } }
#pragma unroll
            for (int o = 1; o < 64; o <<= 1) {
#pragma unroll
                for (int k = 0; k < 8; ++k) ss[k] += __shfl_xor(ss[k], o); }
#pragma unroll
            for (int k = 0; k < 8; ++k) if (lane < 16) SSQB[(size_t)(r4 + k) * 16 + lane] = (lane == 0) ? ss[k] : 0.f;
        }
    }
    if (bx != 0 && threadIdx.x == 0) { unsigned sp = 0; while (xb_ld(&BARW[64]) != 0x600DF1A6u) { __builtin_amdgcn_s_sleep(1); if (++sp > (1u << 22)) break; } }
    __syncthreads();
    (void)xcd_barrier_post(BARW, BST);
    if (a.ws == nullptr) grid.sync();
    GRID_BAR();

#pragma unroll 1
    for (int l = 0; l < 2; ++l) {
        unsigned char* wl = ws + WS_W + (size_t)l * W_LAYER;
        const bf16_t* Win_t = (const bf16_t*)(wl + WO_IN); const bf16_t* Wuq_t = (const bf16_t*)(wl + WO_UQ); const bf16_t* Wukv_t = (const bf16_t*)(wl + WO_UKV);
        const bf16_t* Wo_t = (const bf16_t*)(wl + WO_O); const bf16_t* Wgu_t = (const bf16_t*)(wl + WO_GU); const bf16_t* Wd_t = (const bf16_t*)(wl + WO_D);

        if (PH(1)) {
            pg8::Gemm g{XB, Win_t, T_TOK, DINP, DM, DM}; pg8::StaticOrder S; S.init(T_TOK, DINP, G, bx);
            pg8::EpiScaleBf16<0> E{PROJ, DINP, SSQB, RQ, RKV};
            pg8::gemm_phase<pg8::EpiScaleBf16<0>, true>(lds, g, S, E);
        }
        GRID_BAR();

        if (PH(2)) {
            PHASE_IDS;
            {
                const u32x4* img = (const u32x4*)(ws + 57 * MiB) + (size_t)l * 2304;
                for (int i = tid; i < 2304; i += 512) ((LAS u32x4*)lds)[i] = img[i];
            }
            __syncthreads();
            const float* conv_w = a.in[I_CONV_W] + (size_t)l * 3 * 256;
            const float* pscale = a.in[I_POOL_SCALE] + (size_t)l * 256;
#pragma unroll 1
            for (int tile = vcu * 8 + wave; tile < T_TOK / 16; tile += NGW) {
                const int r0 = tile * 16;
                {
                    int ln = lane; asm volatile("" : "+v"(ln));
                    const int t = ln & 15, kq = ln >> 4, row = r0 + t, pos = row & (SEQ - 1);
                    const bf16_t* up = PROJ + (size_t)row * DINP + OFF_UP + 8 * kq;
                    f32x4 acc[4][4]; float ss = 0.f;
#pragma unroll
                    for (int g = 0; g < 4; ++g) {
                        const int w = 2 << g;
                        const float inv = 1.0f / (float)((pos + 1 < w) ? pos + 1 : w);
                        bf16x8 pf[2];
#pragma unroll
                        for (int ks = 0; ks < 2; ++ks) {
                            const bf16_t* p = up + 64 * g + 32 * ks;
                            const u32x4 v0 = *(const u32x4*)p;
                            float sm[8] = {bf_lo(v0.x), bf_hi(v0.x), bf_lo(v0.y), bf_hi(v0.y), bf_lo(v0.z), bf_hi(v0.z), bf_lo(v0.w), bf_hi(v0.w)};
#pragma unroll
                            for (int j = 1; j < w; ++j) {
                                const int jj = (pos >= j) ? j : 0;
                                u32x4 v = *(const u32x4*)(p - (size_t)jj * DINP);
                                const unsigned msk = (pos >= j) ? 0xffffffffu : 0u;
                                v.x &= msk; v.y &= msk; v.z &= msk; v.w &= msk;
                                sm[0] += bf_lo(v.x); sm[1] += bf_hi(v.x); sm[2] += bf_lo(v.y); sm[3] += bf_hi(v.y); sm[4] += bf_lo(v.z); sm[5] += bf_hi(v.z); sm[6] += bf_lo(v.w); sm[7] += bf_hi(v.w);
                            }
                            u32x4 pk;
                            pk.x = cvtpk(sm[0] * inv - bf_lo(v0.x), sm[1] * inv - bf_hi(v0.x)); pk.y = cvtpk(sm[2] * inv - bf_lo(v0.y), sm[3] * inv - bf_hi(v0.y));
                            pk.z = cvtpk(sm[4] * inv - bf_lo(v0.z), sm[5] * inv - bf_hi(v0.z)); pk.w = cvtpk(sm[6] * inv - bf_lo(v0.w), sm[7] * inv - bf_hi(v0.w));
                            pf[ks] = __builtin_bit_cast(bf16x8, pk);
                            asm volatile("" ::: "memory");
                        }
#pragma unroll
                        for (int nb = 0; nb < 4; ++nb) {
                            f32x4 c = {0.f, 0.f, 0.f, 0.f};
#pragma unroll
                            for (int ks = 0; ks < 2; ++ks) {
                                const bf16x8 wf = *(const LAS bf16x8*)(lds + ((g * 64 + 16 * nb + t) * 72 + 32 * ks + 8 * kq) * 2);
                                c = __builtin_amdgcn_mfma_f32_16x16x32_bf16(wf, pf[ks], c, 0, 0, 0);
                            }
                            c = c * *(const f32x4*)(pscale + 64 * g + 16 * nb + 4 * kq);
                            acc[g][nb] = c; ss += (c.x * c.x + c.y * c.y) + (c.z * c.z + c.w * c.w);
                        }
                    }
                    ss += __shfl_xor(ss, 16); ss += __shfl_xor(ss, 32);
                    const float rs = rsqrtf(ss * (1.0f / 256.0f) + RMS_EPS);
                    bf16_t* yo = YB + (size_t)row * DM + 512 + 4 * kq;
#pragma unroll
                    for (int g = 0; g < 4; ++g)
#pragma unroll
                        for (int nb = 0; nb < 4; ++nb) *(u32x2*)(yo + 64 * g + 16 * nb) = pack4(acc[g][nb] * rs);
                    const bf16_t* kr = PROJ + (size_t)row * DINP + OFF_KR + 4 * kq;
                    const f32x4 x1 = unpack4(*(const u32x2*)kr), x2 = unpack4(*(const u32x2*)(kr + 16));
                    const f32x4 cs = *(const f32x4*)(cosT + pos * 16 + 4 * kq), sn = *(const f32x4*)(sinT + pos * 16 + 4 * kq);
                    *(u32x2*)(KR + (size_t)row * 32 + 4 * kq) = pack4(x1 * cs - x2 * sn);
                    *(u32x2*)(KR + (size_t)row * 32 + 16 + 4 * kq) = pack4(x1 * sn + x2 * cs);
                }
#pragma unroll 1
                for (int ps = 0; ps < 2; ++ps) {
                    int ln = lane; asm volatile("" : "+v"(ln) :: "memory");
                    const int rsub = ln >> 3, c8 = ln & 7, row = r0 + 8 * ps + rsub, pos = row & (SEQ - 1);
                    const bf16_t* pr = PROJ + (size_t)row * DINP + 8 * c8;
                    float sy = 0.f;
                    float y[4][8];
#pragma unroll
                    for (int i = 0; i < 4; ++i) {
                        const u32x4 gb = *(const u32x4*)(pr + OFF_GB + 64 * i);
                        const u32x4 gc0 = *(const u32x4*)(pr + OFF_GC + 64 * i), uc0 = *(const u32x4*)(pr + OFF_UC + 64 * i);
                        u32x4 gc1 = {0u, 0u, 0u, 0u}, uc1 = gc1, gc2 = gc1, uc2 = gc1;
                        if (pos >= 1) { gc1 = *(const u32x4*)(pr - DINP + OFF_GC + 64 * i); uc1 = *(const u32x4*)(pr - DINP + OFF_UC + 64 * i); }
                        if (pos >= 2) { gc2 = *(const u32x4*)(pr - 2 * DINP + OFF_GC + 64 * i); uc2 = *(const u32x4*)(pr - 2 * DINP + OFF_UC + 64 * i); }
                        const float* cw = conv_w + 64 * i + 8 * c8;
                        const f32x4 wa0 = *(const f32x4*)(cw), wa1 = *(const f32x4*)(cw + 4), wb0 = *(const f32x4*)(cw + 256), wb1 = *(const f32x4*)(cw + 260), wc0 = *(const f32x4*)(cw + 512), wc1 = *(const f32x4*)(cw + 516);
                        const unsigned gbw[4] = {gb.x, gb.y, gb.z, gb.w}, g0w[4] = {gc0.x, gc0.y, gc0.z, gc0.w}, u0w[4] = {uc0.x, uc0.y, uc0.z, uc0.w};
                        const unsigned g1w[4] = {gc1.x, gc1.y, gc1.z, gc1.w}, u1w[4] = {uc1.x, uc1.y, uc1.z, uc1.w}, g2w[4] = {gc2.x, gc2.y, gc2.z, gc2.w}, u2w[4] = {uc2.x, uc2.y, uc2.z, uc2.w};
                        const float wA[8] = {wa0.x, wa0.y, wa0.z, wa0.w, wa1.x, wa1.y, wa1.z, wa1.w}, wB[8] = {wb0.x, wb0.y, wb0.z, wb0.w, wb1.x, wb1.y, wb1.z, wb1.w}, wC[8] = {wc0.x, wc0.y, wc0.z, wc0.w, wc1.x, wc1.y, wc1.z, wc1.w};
#pragma unroll
                        for (int e = 0; e < 4; ++e) {
                            const float zl2 = bf_lo(g2w[e]) * bf_lo(u2w[e]), zh2 = bf_hi(g2w[e]) * bf_hi(u2w[e]);
                            const float zl1 = bf_lo(g1w[e]) * bf_lo(u1w[e]), zh1 = bf_hi(g1w[e]) * bf_hi(u1w[e]);
                            const float zl0 = bf_lo(g0w[e]) * bf_lo(u0w[e]), zh0 = bf_hi(g0w[e]) * bf_hi(u0w[e]);
                            const float yl = bf_lo(gbw[e]) * (wA[2 * e] * zl2 + wB[2 * e] * zl1 + wC[2 * e] * zl0);
                            const float yh = bf_hi(gbw[e]) * (wA[2 * e + 1] * zh2 + wB[2 * e + 1] * zh1 + wC[2 * e + 1] * zh0);
                            y[i][2 * e] = yl; y[i][2 * e + 1] = yh; sy += yl * yl + yh * yh;
                        }
                        if (i & 1) asm volatile("" ::: "memory");
                    }
#pragma unroll
                    for (int o = 1; o < 8; o <<= 1) sy += __shfl_xor(sy, o);
                    const float rs = rsqrtf(sy * (1.0f / 256.0f) + RMS_EPS);
#pragma unroll
                    for (int i = 0; i < 4; ++i) { u32x4 w; w.x = cvtpk(y[i][0] * rs, y[i][1] * rs); w.y = cvtpk(y[i][2] * rs, y[i][3] * rs); w.z = cvtpk(y[i][4] * rs, y[i][5] * rs); w.w = cvtpk(y[i][6] * rs, y[i][7] * rs);
                        *(u32x4*)(YB + (size_t)row * DM + 256 + 64 * i + 8 * c8) = w; }
                }
            }
            __syncthreads();
        }
        if (PH(3)) {
            const float* sinks = a.in[I_SWA_SINKS] + l * 4;
            for (int it0 = vcu; it0 < 512; it0 += G) {
                int it = it0;
                if (G == 256) { const int u = (vcu & 31) * 2 + (it0 >> 8); it = ((vcu >> 5) * 4 + (u >> 4)) * 16 + (u & 15); }
                const int bh = it >> 4, qb = it & 15, b = bh >> 2, hq = bh & 3, kvh = hq >> 1;
                const bf16_t* base = PROJ + (size_t)b * SEQ * DINP;
                const float slope = exp2f(-8.0f * (float)(hq + 1) / 4.0f);
                att::unit<true>(lds, base + OFF_QSW + hq * 64, DINP, base + OFF_KSW + kvh * 64, DINP, nullptr, base + OFF_VSW + kvh * 64, DINP,
                                YB + (size_t)b * SEQ * DM + 768 + hq * 64, SSQH + (size_t)b * SEQ * 8 + 4 + hq, qb * 256, 0.125f * LOG2E, slope * LOG2E, sinks[hq] * LOG2E);
            }
        }

        if (PH(4)) {
            pg8::Gemm g{PROJ + OFF_CQ, Wuq_t, T_TOK, 512, 256, DINP}; pg8::StaticOrder S; S.init(T_TOK, 512, G, bx);
            pg8::EpiQRope E{QM, RQ, cosT, sinT};
            pg8::gemm_phase<pg8::EpiQRope, true>(lds, g, S, E);
        }
        if (PH(5)) {
            pg8::Gemm g{PROJ + OFF_CKV, Wukv_t, T_TOK, 512, 128, DINP}; pg8::StaticOrder S; S.init(T_TOK, 512, G, bx);
            pg8::EpiScaleBf16<1> E{KV, 512, RKV, nullptr, nullptr};
            pg8::gemm_phase<pg8::EpiScaleBf16<1>, true>(lds, g, S, E);
        }
        GRID_BAR();

        if (PH(6)) for (int it = vcu; it < 256; it += G) {
            const int bh = it >> 3, s = it & 7, b = bh >> 2, h = bh & 3;
            const float csc = LOG2E * 0.10206207261596577f;
#pragma unroll 1
            for (int k = 0; k < 2; ++k) {
                const int qb = k == 0 ? s : 15 - s;
                att::unit<false>(lds, QM + (size_t)b * SEQ * 512 + h * 96, 512, KV + (size_t)b * SEQ * 512 + h * 128, 512, KR + (size_t)b * SEQ * 32,
                                 KV + (size_t)b * SEQ * 512 + h * 128 + 64, 512, YB + (size_t)b * SEQ * DM + h * 64, SSQH + (size_t)b * SEQ * 8 + h, qb * 256, csc, 0.f, 0.f);
            }
        }
        GRID_BAR();

        if (PH(8)) {
            pg8::Gemm g{YB, Wo_t, T_TOK, DM, DM, DM}; pg8::StaticOrder S; S.init(T_TOK, DM, G, bx);
            pg8::EpiResidT<true> E{XB, SSQA, SSQH};
            pg8::gemm_phase<pg8::EpiResidT<true>, true>(lds, g, S, E);
        }
        GRID_BAR();

        if (PH(9)) {
            pg8::Gemm g{XB, Wgu_t, T_TOK, 2 * DFF, DM, DM}; pg8::StaticOrder S; S.init(T_TOK, 2 * DFF, G, bx);
            pg8::EpiSwiGLU E{ACT, SSQA};
            pg8::gemm_phase<pg8::EpiSwiGLU, true>(lds, g, S, E);
        }
        GRID_BAR();

        if (PH(10)) {
            pg8::Gemm g{ACT, Wd_t, T_TOK, DM, DFF, DFF}; pg8::StaticOrder S; S.init(T_TOK, DM, G, bx);
            pg8::EpiResidT<false> E{XB, SSQB, nullptr};
            pg8::gemm_phase<pg8::EpiResidT<false>, true>(lds, g, S, E);
        }
        GRID_BAR();
    }

    if (bx == 0 && threadIdx.x == 0) __hip_atomic_store(&BARW[64], 0u, __ATOMIC_RELAXED, __HIP_MEMORY_SCOPE_AGENT);
    if (PH(11)) {
        PHASE_IDS;
        const float* fg = a.in[I_FINAL_NORM];
        f32x4 gv[4];
#pragma unroll
        for (int j = 0; j < 4; ++j) gv[j] = ((const f32x4*)fg)[64 * j + lane];
#pragma unroll 1
        for (int r16 = (vcu * 8 + wave) * 16; r16 < T_TOK; r16 += NGW * 16)
#pragma unroll 1
        for (int r4 = r16; r4 < r16 + 16; r4 += 4) {
            u32x2 v[4][4]; float rs[4];
#pragma unroll
            for (int k = 0; k < 4; ++k) {
#pragma unroll
                for (int j = 0; j < 4; ++j) v[k][j] = ((const u32x2*)(XB + (size_t)(r4 + k) * DM) + lane)[64 * j];
                rs[k] = pg8::rstd_from_partials(SSQB, r4 + k);
            }
#pragma unroll
            for (int k = 0; k < 4; ++k)
#pragma unroll
                for (int j = 0; j < 4; ++j) __builtin_nontemporal_store(unpack4(v[k][j]) * rs[k] * gv[j], (f32x4*)(OUT + (size_t)(r4 + k) * DM) + lane + 64 * j);
        }
    }
}

extern "C" void kernel_launch(void* const* d_in, const int* in_sizes, int n_in, void* d_out, int out_size, void* d_ws, size_t ws_size, hipStream_t stream) {
    static int grid = 0;
    if (grid == 0) {
        if (n_in != 17 || out_size != T_TOK * DM || ws_size < WS_END) { fprintf(stderr, "kernel_launch: unexpected problem shape (n_in %d out %d ws %zu)\n", n_in, out_size, ws_size); grid = -1; return; }
        int dev = 0, cus = 0, per_cu = 0;
        hipGetDevice(&dev);
        hipDeviceGetAttribute(&cus, hipDeviceAttributeMultiprocessorCount, dev);
        hipFuncSetAttribute((const void*)fwd_kernel, hipFuncAttributeMaxDynamicSharedMemorySize, LDS_BYTES);
        hipOccupancyMaxActiveBlocksPerMultiprocessor(&per_cu, (const void*)fwd_kernel, 512, LDS_BYTES);
        if (per_cu < 1) { fprintf(stderr, "kernel_launch: occupancy query says %d blocks per CU\n", per_cu); per_cu = 1; }
        (void)hipGetLastError();
        grid = cus * 1;
        if ((T_TOK / 256) * (DM / 256) > 3 * grid) { fprintf(stderr, "kernel_launch: %d CUs are too few for the per-phase factor tables of this kernel (needs >= 171)\n", cus); grid = -1; return; }
    }
    if (grid < 0) return;
    Args a{};
    for (int i = 0; i < 17; ++i) a.in[i] = (const float*)d_in[i];
    a.out = (float*)d_out; a.ws = (unsigned char*)d_ws;
    void* args[] = {&a};
    hipError_t e = hipLaunchCooperativeKernel((const void*)fwd_kernel, dim3(grid), dim3(512), args, LDS_BYTES, stream);
    if (e != hipSuccess) fprintf(stderr, "cooperative launch failed: %s (grid %d)\n", hipGetErrorString(e), grid);
}
```

```cpp
#include <hip/hip_runtime.h>
#include <hip/hip_cooperative_groups.h>
#include <cstdio>
#include <cstdint>
namespace cg = cooperative_groups;

#define LAS __attribute__((address_space(3)))
typedef unsigned short bf16_t;
typedef short bf16x8 __attribute__((ext_vector_type(8)));
typedef float f32x4 __attribute__((ext_vector_type(4)));
typedef float f32x16 __attribute__((ext_vector_type(16)));
typedef unsigned u32x4 __attribute__((ext_vector_type(4)));
typedef unsigned u32x2 __attribute__((ext_vector_type(2)));
typedef short s16x4 __attribute__((ext_vector_type(4)));
typedef float f32x2_t __attribute__((ext_vector_type(2)));
typedef __bf16 bf16x2_t __attribute__((ext_vector_type(2)));

constexpr int T_TOK = 32768, SEQ = 4096, DM = 1024, DIN = 1952, DINP = 2048, DFF = 2816;
constexpr int OFF_CQ = 0, OFF_CKV = 256, OFF_KR = 384, OFF_GB = 416, OFF_GC = 672, OFF_UC = 928, OFF_UP = 1184, OFF_QSW = 1440, OFF_KSW = 1696, OFF_VSW = 1824;
constexpr float RMS_EPS = 1e-6f;
constexpr float LOG2E = 1.4426950408889634f;

constexpr size_t MiB = 1u << 20;
constexpr size_t WS_COS = 1 * MiB, WS_SIN = WS_COS + 256 * 1024, WS_RQ = 54 * MiB, WS_RKV = 55 * MiB;
constexpr size_t WS_W = 2 * MiB, W_LAYER = 23 * MiB;
constexpr size_t WO_IN = 0, WO_UQ = 4 * MiB, WO_UKV = WO_UQ + 256 * 1024, WO_O = WO_UKV + 256 * 1024, WO_GU = WO_O + 2 * MiB, WO_D = WO_GU + 11 * MiB;
constexpr size_t WS_SSQA = 48 * MiB, WS_SSQB = 50 * MiB, WS_KR = 52 * MiB;
constexpr size_t WS_XB = 64 * MiB, WS_YB = 128 * MiB, WS_PROJ = 192 * MiB, WS_QM = 320 * MiB, WS_KV = 352 * MiB, WS_ACT = 192 * MiB, WS_END = 384 * MiB;

#ifndef PH_MASK
#define PH_MASK 0xFFFF
#endif
#define PH(n) ((PH_MASK >> (n)) & 1)
constexpr int LDS_BYTES = 147456;

__device__ __forceinline__ unsigned cvtpk(float lo, float hi) { f32x2_t v = {lo, hi}; bf16x2_t b = __builtin_convertvector(v, bf16x2_t); return __builtin_bit_cast(unsigned, b); }
__device__ __forceinline__ float bf_lo(unsigned u) { return __uint_as_float(u << 16); }
__device__ __forceinline__ float bf_hi(unsigned u) { return __uint_as_float(u & 0xffff0000u); }
__device__ __forceinline__ float bf1(bf16_t u) { return __uint_as_float(((unsigned)u) << 16); }
__device__ __forceinline__ f32x4 unpack4(u32x2 v) { return (f32x4){bf_lo(v.x), bf_hi(v.x), bf_lo(v.y), bf_hi(v.y)}; }
__device__ __forceinline__ u32x2 pack4(f32x4 v) { u32x2 r; r.x = cvtpk(v.x, v.y); r.y = cvtpk(v.z, v.w); return r; }
__device__ __forceinline__ int opaque_tid() { int t = threadIdx.x; asm volatile("" : "+v"(t)); return t; }
__device__ __forceinline__ float wave_sum(float v) {
#pragma unroll
    for (int o = 1; o < 64; o <<= 1) v += __shfl_xor(v, o);
    return v;
}

namespace pg8 {
constexpr int BM = 256, BK = 64, HALF = 128, HTB = HALF * BK * 2, STAGE_BYTES = 8 * HTB, NXCD = 8, WGM = 8;
__host__ __device__ __forceinline__ int lds_byte(int r, int c) { const int st = (r >> 4) * 2 + (c >> 5), rr = r & 15, cc = c & 31, ob = rr * 64 + cc * 2; return st * 1024 + (ob ^ (((ob >> 9) & 1) << 5)); }
__host__ __device__ __forceinline__ void stage_rc(int b, int& R, int& C) { const int st = b / 1024, sb = b % 1024, swz = sb ^ (((sb >> 9) & 1) << 5); R = (st >> 1) * 16 + swz / 64; C = (st & 1) * 32 + (swz % 64) / 2; }
__host__ __device__ __forceinline__ int perm32(int rho) { const int n = rho >> 4, i = rho & 15; return 8 * (i >> 2) + 4 * n + (i & 3); }

struct Unit { int pm, pn; };
struct Gemm { const bf16_t* A; const bf16_t* Bt; int M, N, K, lda; };

struct StaticOrder {
    int nM, nN, nwg, G, c;
    __device__ void init(int M, int N, int G_, int c_) { nM = M / BM; nN = N / BM; nwg = nM * nN; G = G_; c = c_; }
    __device__ bool next(int i, Unit& u) const {
        const long L = (long)i * G + c; if (L >= nwg) return false;
        int wgid = (int)L; { const int q = nwg / NXCD, r = nwg % NXCD, xcd = wgid % NXCD, off = wgid / NXCD; wgid = (xcd < r ? xcd * (q + 1) : r * (q + 1) + (xcd - r) * q) + off; }
        const int nig = WGM * nN, gid = wgid / nig, fm = gid * WGM, gsz = (nM - fm) < WGM ? (nM - fm) : WGM;
        u.pm = fm + ((wgid % nig) % gsz); u.pn = (wgid % nig) / gsz; return true;
    }
};

__device__ __forceinline__ float rstd_from_partials(const float* ssq, int row) {
    const f32x4* p = (const f32x4*)(ssq + (size_t)row * 16);
    const f32x4 a = (p[0] + p[1]) + (p[2] + p[3]);
    return rsqrtf(((a.x + a.y) + (a.z + a.w)) * (1.0f / 1024.0f) + RMS_EPS);
}

template <int MODE> struct EpiScaleBf16 {
    static constexpr bool PERM = true, GS = false, RTAB = true;
    __device__ __forceinline__ float tab_value(int row) const {
        if (MODE == 0) return rstd_from_partials(rsv, row);
        const f32x4 p = *(const f32x4*)(rsv + (size_t)row * 4); return rsqrtf(((p.x + p.y) + (p.z + p.w)) * (1.0f / 128.0f) + RMS_EPS);
    }
    bf16_t* O; int ldc; const float* rsv; float* rqp; float* rkvp;
    __device__ __forceinline__ void operator()(const f32x4 (&acc)[2][2][4][2], const Unit& u, int wr, int wc, int fr, int fq, const LAS float* tab) const {
        const int row0 = u.pm * BM + wr * 64 + fr, col0 = u.pn * BM + wc * 32 + 8 * fq;
#pragma unroll
        for (int ai = 0; ai < 2; ++ai)
#pragma unroll
            for (int m = 0; m < 4; ++m) {
                const int row = row0 + ai * HALF + m * 16;
                const float rs = tab ? tab[ai * HALF + wr * 64 + m * 16 + fr] : tab_value(row);
                bf16_t* rowp = O + (size_t)row * ldc + col0;
                float sq0 = 0.f, sq1 = 0.f;
#pragma unroll
                for (int bj = 0; bj < 2; ++bj) {
                    const f32x4 v0 = acc[ai][bj][m][0] * rs, v1 = acc[ai][bj][m][1] * rs;
                    u32x4 w; w.x = cvtpk(v0[0], v0[1]); w.y = cvtpk(v0[2], v0[3]); w.z = cvtpk(v1[0], v1[1]); w.w = cvtpk(v1[2], v1[3]);
                    *(u32x4*)(rowp + bj * HALF) = w;
                    if (MODE == 0) { const float q = ((v0[0] * v0[0] + v0[1] * v0[1]) + (v0[2] * v0[2] + v0[3] * v0[3])) + ((v1[0] * v1[0] + v1[1] * v1[1]) + (v1[2] * v1[2] + v1[3] * v1[3])); if (bj == 0) sq0 = q; else sq1 = q; }
                }
                if (MODE == 0 && u.pn < 2) {
                    float q = (u.pn == 0) ? sq0 + sq1 : sq0;
                    q += __shfl_xor(q, 16); q += __shfl_xor(q, 32);
                    if (fq == 0) { float* dst = (u.pn == 0) ? rqp : rkvp; dst[(size_t)row * 4 + wc] = q; }
                }
            }
    }
};

struct EpiQRope {
    static constexpr bool PERM = false, GS = false, RTAB = true;
    __device__ __forceinline__ float tab_value(int row) const { const f32x4 pq = *(const f32x4*)(rq + (size_t)row * 4); return rsqrtf(((pq.x + pq.y) + (pq.z + pq.w)) * (1.0f / 256.0f) + RMS_EPS); }
    bf16_t* O; const float* rq; const float* cosT; const float* sinT;
    __device__ __forceinline__ void operator()(const f32x4 (&acc)[2][2][4][2], const Unit& u, int wr, int wc, int fr, int fq, const LAS float* tab) const {
        const int row0 = u.pm * BM + wr * 64 + fr;
#pragma unroll
        for (int ai = 0; ai < 2; ++ai)
#pragma unroll
            for (int m = 0; m < 4; ++m) {
                const int row = row0 + ai * HALF + m * 16;
                const float rs = tab ? tab[ai * HALF + wr * 64 + m * 16 + fr] : tab_value(row);
                const int pos = row & (SEQ - 1);
#pragma unroll
                for (int bj = 0; bj < 2; ++bj) {
                    const int cb = u.pn * BM + bj * HALF + wc * 32;
                    if (cb >= 384) continue;
                    const int g32 = cb >> 5;
                    f32x4 x0 = acc[ai][bj][m][0] * rs, x1 = acc[ai][bj][m][1] * rs;
                    if (g32 == 2 || g32 == 5 || g32 == 8 || g32 == 11) {
                        const f32x4 c4 = *(const f32x4*)(cosT + pos * 16 + 4 * fq), s4 = *(const f32x4*)(sinT + pos * 16 + 4 * fq);
                        const f32x4 o0 = x0 * c4 - x1 * s4, o1 = x0 * s4 + x1 * c4; x0 = o0; x1 = o1;
                    }
                    bf16_t* p = O + (size_t)row * 512 + cb + 4 * fq;
                    *(u32x2*)p = pack4(x0); *(u32x2*)(p + 16) = pack4(x1);
                }
            }
    }
};

template <bool GS_> struct EpiResidT {
    static constexpr bool PERM = true, GS = GS_, RTAB = false;
    bf16_t* xb; float* ssq; const float* ssqh;
    __device__ __forceinline__ void operator()(const f32x4 (&acc)[2][2][4][2], const Unit& u, int wr, int wc, int fr, int fq, const LAS float* tab) const {
        const int row0 = u.pm * BM + wr * 64 + fr, col0 = u.pn * BM + wc * 32 + 8 * fq;
        u32x4 ball[2][4][2];
        if (!GS) {
#pragma unroll
            for (int ai = 0; ai < 2; ++ai)
#pragma unroll
                for (int m = 0; m < 4; ++m)
#pragma unroll
                    for (int bj = 0; bj < 2; ++bj) ball[ai][m][bj] = *(const u32x4*)(xb + (size_t)(row0 + ai * HALF + m * 16) * DM + col0 + bj * HALF);
        }
#pragma unroll
        for (int ai = 0; ai < 2; ++ai) {
            u32x4 bpre[4][2];
#pragma unroll
            for (int m = 0; m < 4; ++m)
#pragma unroll
                for (int bj = 0; bj < 2; ++bj) { if (GS) bpre[m][bj] = *(const u32x4*)(xb + (size_t)(row0 + ai * HALF + m * 16) * DM + col0 + bj * HALF); else bpre[m][bj] = ball[ai][m][bj]; }
#pragma unroll
            for (int m = 0; m < 4; ++m) {
                const int row = row0 + ai * HALF + m * 16; bf16_t* rowp = xb + (size_t)row * DM + col0;
                float ss = 0.f, fs = 1.0f;
                if (GS) fs = tab[4 * (ai * HALF + wr * 64 + m * 16 + fr) + 2];
#pragma unroll
                for (int bj = 0; bj < 2; ++bj) {
                    const u32x4 bv = bpre[m][bj];
                    const f32x4 a0 = GS ? acc[ai][bj][m][0] * fs : acc[ai][bj][m][0], a1 = GS ? acc[ai][bj][m][1] * fs : acc[ai][bj][m][1];
                    const f32x4 o0 = {bf_lo(bv.x) + a0.x, bf_hi(bv.x) + a0.y, bf_lo(bv.y) + a0.z, bf_hi(bv.y) + a0.w};
                    const f32x4 o1 = {bf_lo(bv.z) + a1.x, bf_hi(bv.z) + a1.y, bf_lo(bv.w) + a1.z, bf_hi(bv.w) + a1.w};
                    u32x4 w; w.x = cvtpk(o0.x, o0.y); w.y = cvtpk(o0.z, o0.w); w.z = cvtpk(o1.x, o1.y); w.w = cvtpk(o1.z, o1.w);
                    *(u32x4*)(rowp + bj * HALF) = w;
                    ss += ((o0.x * o0.x + o0.y * o0.y) + (o0.z * o0.z + o0.w * o0.w)) + ((o1.x * o1.x + o1.y * o1.y) + (o1.z * o1.z + o1.w * o1.w));
                }
                ss += __shfl_xor(ss, 16); ss += __shfl_xor(ss, 32);
                if (fq == 0) ssq[(size_t)row * 16 + u.pn * 4 + wc] = ss;
            }
        }
    }
};

struct EpiSwiGLU {
    static constexpr bool PERM = true, GS = false, RTAB = true;
    __device__ __forceinline__ float tab_value(int row) const { return rstd_from_partials(ssq, row); }
    bf16_t* O; const float* ssq;
    __device__ __forceinline__ void operator()(const f32x4 (&acc)[2][2][4][2], const Unit& u, int wr, int wc, int fr, int fq, const LAS float* tab) const {
        const int row0 = u.pm * BM + wr * 64 + fr, col0 = u.pn * HALF + wc * 32 + 8 * fq;
#pragma unroll
        for (int ai = 0; ai < 2; ++ai)
#pragma unroll
            for (int m = 0; m < 4; ++m) {
                const int row = row0 + ai * HALF + m * 16;
                const float rs = tab ? tab[ai * HALF + wr * 64 + m * 16 + fr] : rstd_from_partials(ssq, row);
                float r[8];
#pragma unroll
                for (int n = 0; n < 2; ++n)
#pragma unroll
                    for (int i = 0; i < 4; ++i) {
                        const float g = acc[ai][0][m][n][i] * rs, up = acc[ai][1][m][n][i] * rs;
                        const float sg = __builtin_amdgcn_rcpf(1.0f + __builtin_amdgcn_exp2f(-g * LOG2E));
                        r[n * 4 + i] = g * sg * up;
                    }
                u32x4 w; w.x = cvtpk(r[0], r[1]); w.y = cvtpk(r[2], r[3]); w.z = cvtpk(r[4], r[5]); w.w = cvtpk(r[6], r[7]);
                *(u32x4*)(O + (size_t)row * DFF + col0) = w;
            }
    }
};

template <class Epi, bool ALIGN_EPI>
__device__ __forceinline__ void gemm_phase(LAS unsigned char* lds, const Gemm g, const StaticOrder& S, const Epi& E) {
    const int tid = opaque_tid(), wid = __builtin_amdgcn_readfirstlane(tid >> 6), lane = tid & 63, wr = wid >> 2, wc = wid & 3, fr = lane & 15, fq = lane >> 4;
    int K = g.K; asm volatile("" : "+s"(K));
    const int nt = K / BK, lda = g.lda;
    unsigned voffA[2], voffB[2];
#pragma unroll
    for (int i = 0; i < 2; ++i) { int R, C; stage_rc(tid * 16 + i * 8192, R, C); const int Rb = Epi::PERM ? ((R & ~31) + perm32(R & 31)) : R;
        voffA[i] = (unsigned)(R * lda + C) * 2u; voffB[i] = (unsigned)(Rb * K + C) * 2u; }
    const size_t kstep = (size_t)(BK * 2);
    const size_t hstepA = (size_t)HALF * lda * 2, hstepB = (size_t)HALF * K * 2;
    const size_t tstepA = 2 * hstepA, tstepB = 2 * hstepB;
    const unsigned ldsw = (unsigned)wid * 1024u;
    const int aoff = lds_byte(wr * 64 + fr, fq * 8), boff = lds_byte(wc * 32 + fr, fq * 8);
#define PG8_SA(b, h) (((b) * 2 + (h)) * HTB)
#define PG8_SB(b, h) ((4 + (b) * 2 + (h)) * HTB)
#define PG8_STAGE(bufoff, gbase, voff) do { _Pragma("unroll") for (int _i = 0; _i < 2; ++_i) \
        __builtin_amdgcn_global_load_lds((const unsigned*)((const char*)(gbase) + (voff)[_i]), (LAS unsigned*)(lds + (bufoff) + ldsw + _i * 8192), 16, 0, 0); } while (0)
#define PG8_LDA(dst, b, h) do { _Pragma("unroll") for (int m = 0; m < 4; ++m) _Pragma("unroll") for (int k = 0; k < 2; ++k) dst[m][k] = *(const LAS bf16x8*)(lds + PG8_SA(b, h) + aoff + m * 2048 + k * 1024); } while (0)
#define PG8_LDB(dst, b, h) do { _Pragma("unroll") for (int n = 0; n < 2; ++n) _Pragma("unroll") for (int k = 0; k < 2; ++k) dst[n][k] = *(const LAS bf16x8*)(lds + PG8_SB(b, h) + boff + n * 2048 + k * 1024); } while (0)
#define PG8_MMA(ai, bj, At, Bt) do { __builtin_amdgcn_s_setprio(1); _Pragma("unroll") for (int m = 0; m < 4; ++m) _Pragma("unroll") for (int n = 0; n < 2; ++n) _Pragma("unroll") for (int k = 0; k < 2; ++k) \
        acc[ai][bj][m][n] = __builtin_amdgcn_mfma_f32_16x16x32_bf16(Bt[n][k], At[m][k], acc[ai][bj][m][n], 0, 0, 0); __builtin_amdgcn_s_setprio(0); } while (0)
#define PG8_WAIT_V(n) asm volatile("s_waitcnt vmcnt(" #n ")" ::: "memory")
#define PG8_WAIT_L(n) asm volatile("s_waitcnt lgkmcnt(" #n ")" ::: "memory")
#define PG8_BAR __builtin_amdgcn_s_barrier()
#define PG8_SCHED __builtin_amdgcn_sched_barrier(0)
    Unit cur, nxt; int ui = 0;
    if (!S.next(0, cur)) return;
    f32x4 acc[2][2][4][2];
#pragma unroll
    for (int a = 0; a < 2; ++a)
#pragma unroll
        for (int b = 0; b < 2; ++b)
#pragma unroll
            for (int m = 0; m < 4; ++m)
#pragma unroll
                for (int n = 0; n < 2; ++n) acc[a][b][m][n] = (f32x4){0.f, 0.f, 0.f, 0.f};
    bf16x8 At[4][2], B0[2][2], B1[2][2];
    const char* cA = (const char*)g.A + (size_t)cur.pm * tstepA; const char* cB = (const char*)g.Bt + (size_t)cur.pn * tstepB;
    constexpr int GS_MAX = 3;
    LAS f32x4* gtab = (LAS f32x4*)(lds + STAGE_BYTES + 1024);
    if constexpr (Epi::GS) { Unit tu_; for (int i_ = 0; i_ < GS_MAX && S.next(i_, tu_); ++i_) { if (tid < 256) { const float* sp_ = E.ssqh + (size_t)(tu_.pm * BM + tid) * 8; const f32x4 pa_ = *(const f32x4*)sp_, pd_ = *(const f32x4*)(sp_ + 4);
        const float ma_ = ((pa_.x + pa_.y) + (pa_.z + pa_.w)) * (1.0f / 256.0f) + RMS_EPS, md_ = ((pd_.x + pd_.y) + (pd_.z + pd_.w)) * (1.0f / 256.0f) + RMS_EPS;
        gtab[i_ * 256 + tid] = (f32x4){rsqrtf(ma_), sqrtf(md_), rsqrtf(md_), 0.f}; } } }
#define PG8_GS_SCALE(sel_) do { _Pragma("unroll") for (int a_ = 0; a_ < 2; ++a_) _Pragma("unroll") for (int m_ = 0; m_ < 4; ++m_) { const int rl_ = a_ * HALF + wr * 64 + m_ * 16 + fr; float fa_, fd_; \
        { const f32x4 f4_ = gtab[ui * 256 + rl_]; fa_ = f4_.x; fd_ = f4_.y; }     \
        const float f_ = (sel_) == 0 ? 1.0f : ((sel_) == 1 ? fa_ : fd_); \
        _Pragma("unroll") for (int b_ = 0; b_ < 2; ++b_) _Pragma("unroll") for (int n_ = 0; n_ < 2; ++n_) acc[a_][b_][m_][n_] = acc[a_][b_][m_][n_] * f_; __builtin_amdgcn_sched_barrier(0); } } while (0)
    constexpr int RT_MAX = 11;
    LAS float* rtab = (LAS float*)(lds + STAGE_BYTES + 4096);
    if constexpr (Epi::RTAB) { Unit tu_; for (int i_ = 0; i_ < RT_MAX && S.next(i_, tu_); ++i_) { if (tid < 256) rtab[i_ * 256 + tid] = E.tab_value(tu_.pm * BM + tid); } }
    PG8_STAGE(PG8_SB(0, 0), cB, voffB); PG8_STAGE(PG8_SB(0, 1), cB + hstepB, voffB); PG8_STAGE(PG8_SA(0, 0), cA, voffA); PG8_STAGE(PG8_SA(0, 1), cA + hstepA, voffA);
    if (wr == 1) PG8_BAR;
    PG8_WAIT_V(2); PG8_BAR;
    PG8_STAGE(PG8_SB(1, 0), cB + kstep, voffB); PG8_STAGE(PG8_SA(1, 0), cA + kstep, voffA); PG8_STAGE(PG8_SB(1, 1), cB + hstepB + kstep, voffB);
    PG8_WAIT_V(6); PG8_BAR;
    for (;;) {
        const bool has_next = S.next(ui + 1, nxt);
        const char* nA = has_next ? (const char*)g.A + (size_t)nxt.pm * tstepA : cA; const char* nB = has_next ? (const char*)g.Bt + (size_t)nxt.pn * tstepB : cB;
#pragma unroll 1
        for (int seg = 0; seg < (Epi::GS ? 3 : 1); ++seg) {
        const int tb = Epi::GS ? (seg == 0 ? 0 : (seg == 1 ? 4 : 12)) : 0, te = Epi::GS ? (seg == 0 ? 4 : (seg == 1 ? 12 : nt)) : nt;
        if constexpr (Epi::GS) { PG8_GS_SCALE(seg); }
#pragma unroll 1
        for (int t = tb; t < te; t += 2) {
            const bool last = (t == nt - 2);
            const char* a1 = cA + (size_t)(t + 1) * kstep;
            const char* a2 = last ? nA : cA + (size_t)(t + 2) * kstep; const char* b2 = last ? nB : cB + (size_t)(t + 2) * kstep;
            const char* a3 = a2 + kstep; const char* b3 = b2 + kstep;
            PG8_LDB(B0, 0, 0); PG8_LDB(B1, 0, 1); PG8_SCHED; PG8_LDA(At, 0, 0); PG8_STAGE(PG8_SA(1, 1), a1 + hstepA, voffA);
            PG8_WAIT_V(8); PG8_WAIT_L(0); PG8_BAR; PG8_MMA(0, 0, At, B0); PG8_MMA(0, 1, At, B1); PG8_BAR; PG8_SCHED;
            PG8_LDA(At, 0, 1); PG8_STAGE(PG8_SB(0, 0), b2, voffB); PG8_STAGE(PG8_SB(0, 1), b2 + hstepB, voffB); PG8_STAGE(PG8_SA(0, 0), a2, voffA);
            PG8_WAIT_V(8); PG8_WAIT_L(0); PG8_BAR; PG8_MMA(1, 0, At, B0); PG8_MMA(1, 1, At, B1); PG8_BAR; PG8_SCHED;
            PG8_LDB(B0, 1, 0); PG8_LDB(B1, 1, 1); PG8_SCHED; PG8_LDA(At, 1, 0); PG8_STAGE(PG8_SA(0, 1), a2 + hstepA, voffA);
            PG8_WAIT_V(8); PG8_WAIT_L(0); PG8_BAR; PG8_MMA(0, 0, At, B0); PG8_MMA(0, 1, At, B1); PG8_BAR; PG8_SCHED;
            PG8_LDA(At, 1, 1); PG8_STAGE(PG8_SB(1, 0), b3, voffB); PG8_STAGE(PG8_SB(1, 1), b3 + hstepB, voffB); PG8_STAGE(PG8_SA(1, 0), a3, voffA);
            PG8_WAIT_V(8); PG8_WAIT_L(0); PG8_BAR; PG8_MMA(1, 0, At, B0); PG8_MMA(1, 1, At, B1); PG8_BAR; PG8_SCHED;
        }
        }
        if constexpr (ALIGN_EPI) { if (wr == 0) PG8_BAR; }
        E(acc, cur, wr, wc, fr, fq, (Epi::RTAB && ui < RT_MAX) ? (const LAS float*)(rtab + ui * 256) : (Epi::GS ? (const LAS float*)(gtab + ui * 256) : (const LAS float*)nullptr));
        if (!has_next) break;
#pragma unroll
        for (int a = 0; a < 2; ++a)
#pragma unroll
            for (int b = 0; b < 2; ++b)
#pragma unroll
                for (int m = 0; m < 4; ++m)
#pragma unroll
                    for (int n = 0; n < 2; ++n) acc[a][b][m][n] = (f32x4){0.f, 0.f, 0.f, 0.f};
        cur = nxt; cA = nA; cB = nB; ++ui;
        if constexpr (ALIGN_EPI) { if (wr == 1) PG8_BAR; }
    }
    PG8_WAIT_V(0);
    if constexpr (!ALIGN_EPI) { if (wr == 0) PG8_BAR; }
    PG8_BAR;
#undef PG8_GS_SCALE
#undef PG8_SA
#undef PG8_SB
#undef PG8_STAGE
#undef PG8_LDA
#undef PG8_LDB
#undef PG8_MMA
#undef PG8_WAIT_V
#undef PG8_WAIT_L
#undef PG8_BAR
#undef PG8_SCHED
}
}

namespace att {
constexpr int KP = 104, VP = 96;
constexpr int KBYTES = 64 * KP * 2, VBYTES = 64 * VP * 2, BUFB = KBYTES + VBYTES;
__device__ __forceinline__ int crow(int r, int hi) { return (r & 3) + 8 * (r >> 2) + 4 * hi; }

template <bool SWA>
__device__ __forceinline__ void unit(LAS unsigned char* lds, const bf16_t* Qp, int qpitch, const bf16_t* K1, int k1pitch, const bf16_t* K2,
                                     const bf16_t* Vp, int vpitch, bf16_t* Yp, float* ssqh, int q0, float cscale, float slope2, float sink2) {
    constexpr int DQK = SWA ? 64 : 96, ND = DQK / 16;
    const int tid = opaque_tid(), lane = tid & 63, wid = __builtin_amdgcn_readfirstlane(tid >> 6), r32 = lane & 31, hi = lane >> 5;
    const int qw = q0 + wid * 32, qrow = qw + r32;
    bf16x8 qf[ND];
#pragma unroll
    for (int d0 = 0; d0 < ND; ++d0) {
        const u32x4 v = *(const u32x4*)(Qp + (size_t)qrow * qpitch + 16 * d0 + 8 * hi);
        u32x4 w; w.x = cvtpk(bf_lo(v.x) * cscale, bf_hi(v.x) * cscale); w.y = cvtpk(bf_lo(v.y) * cscale, bf_hi(v.y) * cscale);
        w.z = cvtpk(bf_lo(v.z) * cscale, bf_hi(v.z) * cscale); w.w = cvtpk(bf_lo(v.w) * cscale, bf_hi(v.w) * cscale);
        qf[d0] = __builtin_bit_cast(bf16x8, w);
    }
    const int t_lo = SWA ? (q0 >= 128 ? (q0 - 128) / 64 : 0) : 0, t_hi = (q0 + 256) / 64;
    constexpr float THR = 8.0f;
    float mrun = SWA ? sink2 : 0.f, lrun = (SWA && hi == 0) ? 1.f : 0.f;
    bool fresh = !SWA;
    f32x16 negm;
#pragma unroll
    for (int r = 0; r < 16; ++r) negm[r] = -mrun;
    f32x16 o0, o1;
#pragma unroll
    for (int r = 0; r < 16; ++r) { o0[r] = 0.f; o1[r] = 0.f; }
    const int k1key = tid >> 3, k1ch = tid & 7, k2key = (tid >> 2) & 63, k2ch = tid & 3;
    const bf16_t* k1src = K1 + (size_t)k1key * k1pitch + k1ch * 8;
    const bf16_t* k2src = SWA ? K1 : (K2 + (size_t)k2key * 32 + k2ch * 8);
    const bf16_t* vsrc = Vp + (size_t)k1key * vpitch + k1ch * 8;
    u32x4 rk1[2], rk2[2], rv[2];
#define ATT_ISSUE(t) do { _Pragma("unroll") for (int s_ = 0; s_ < 2; ++s_) { rk1[s_] = *(const u32x4*)(k1src + (size_t)((t) + s_) * 64 * k1pitch); \
        if (!SWA && tid < 256) rk2[s_] = *(const u32x4*)(k2src + (size_t)((t) + s_) * 64 * 32); \
        rv[s_] = *(const u32x4*)(vsrc + (size_t)((t) + s_) * 64 * vpitch); } } while (0)
    ATT_ISSUE(t_lo);
    for (int tp = t_lo; tp < t_hi; tp += 2) {
        LAS unsigned char* kbp = lds + (((tp - t_lo) >> 1) & 1) * (2 * BUFB);
#pragma unroll
        for (int s_ = 0; s_ < 2; ++s_) {
            LAS unsigned char* kb = kbp + s_ * BUFB;
            LAS unsigned char* vb = kb + KBYTES;
            *(LAS u32x4*)(kb + k1key * (KP * 2) + k1ch * 16) = rk1[s_];
            if (!SWA && tid < 256) *(LAS u32x4*)(kb + k2key * (KP * 2) + 128 + k2ch * 16) = rk2[s_];
            *(LAS u32x4*)(vb + k1key * (VP * 2) + k1ch * 16) = rv[s_];
        }
        __syncthreads();
        if (tp + 2 < t_hi) ATT_ISSUE(tp + 2);
        {
        const int kt0 = 64 * tp;
        bool skipA = kt0 > qw + 31, skipB = kt0 + 64 > qw + 31;
        if (SWA) { skipA = skipA || (kt0 + 63 < qw - 127); skipB = skipB || (kt0 + 127 < qw - 127); }
        if (!(skipA && skipB)) {
            f32x16 p[2][2];
#pragma unroll
            for (int s_ = 0; s_ < 2; ++s_) {
                const LAS unsigned char* kb = kbp + s_ * BUFB;
#pragma unroll
                for (int d0 = 0; d0 < ND; ++d0) {
                    const bf16x8 a0 = *(const LAS bf16x8*)(kb + r32 * (KP * 2) + d0 * 32 + hi * 16);
                    const bf16x8 a1 = *(const LAS bf16x8*)(kb + (32 + r32) * (KP * 2) + d0 * 32 + hi * 16);
                    p[s_][0] = __builtin_amdgcn_mfma_f32_32x32x16_bf16(a0, qf[d0], d0 == 0 ? negm : p[s_][0], 0, 0, 0);
                    p[s_][1] = __builtin_amdgcn_mfma_f32_32x32x16_bf16(a1, qf[d0], d0 == 0 ? negm : p[s_][1], 0, 0, 0);
                }
            }
            const bool need_mask = SWA || (kt0 + 127 > qw);
            if (need_mask) {
#pragma unroll
                for (int s_ = 0; s_ < 2; ++s_)
#pragma unroll
                    for (int r = 0; r < 16; ++r) {
                        const int d0_ = qrow - (kt0 + 64 * s_ + crow(r, hi)), d1_ = d0_ - 32;
                        float s0 = p[s_][0][r], s1 = p[s_][1][r];
                        bool v0 = d0_ >= 0, v1 = d1_ >= 0;
                        if (SWA) { s0 -= slope2 * (float)d0_; s1 -= slope2 * (float)d1_; v0 = v0 && d0_ < 128; v1 = v1 && d1_ < 128; }
                        p[s_][0][r] = v0 ? s0 : -1e30f; p[s_][1][r] = v1 ? s1 : -1e30f;
                    }
            }
            float mx;
            { float a = -1e30f, b = -1e30f;
#pragma unroll
              for (int r = 0; r < 16; r += 2) { a = fmaxf(fmaxf(a, p[0][0][r]), p[0][0][r + 1]); b = fmaxf(fmaxf(b, p[0][1][r]), p[0][1][r + 1]); a = fmaxf(fmaxf(a, p[1][0][r]), p[1][0][r + 1]); b = fmaxf(fmaxf(b, p[1][1][r]), p[1][1][r + 1]); }
              mx = fmaxf(a, b);
              auto rr = __builtin_amdgcn_permlane32_swap(__float_as_uint(mx), __float_as_uint(mx), false, false);
              mx = fmaxf(__uint_as_float(rr[0]), __uint_as_float(rr[1])); }
            const bool resc = fresh || (mx > THR);
            if (__any(resc)) {
                const float delta = fresh ? mx : (mx > THR ? mx : 0.f);
                mrun += delta;
                const float alpha = __builtin_amdgcn_exp2f(-delta);
                lrun *= alpha;
#pragma unroll
                for (int r = 0; r < 16; ++r) { p[0][0][r] -= delta; p[0][1][r] -= delta; p[1][0][r] -= delta; p[1][1][r] -= delta; o0[r] *= alpha; o1[r] *= alpha; negm[r] = -mrun; }
                fresh = false;
            }
            float ls0 = 0.f, ls1 = 0.f;
#pragma unroll
            for (int s_ = 0; s_ < 2; ++s_)
#pragma unroll
                for (int r = 0; r < 16; ++r) { p[s_][0][r] = __builtin_amdgcn_exp2f(p[s_][0][r]); p[s_][1][r] = __builtin_amdgcn_exp2f(p[s_][1][r]); ls0 += p[s_][0][r]; ls1 += p[s_][1][r]; }
            lrun += ls0 + ls1;
#pragma unroll
            for (int s_ = 0; s_ < 2; ++s_) {
                const LAS unsigned char* vb = kbp + s_ * BUFB + KBYTES;
#pragma unroll
                for (int c = 0; c < 4; ++c) {
                    const f32x16& ps = p[s_][c >> 1]; const int b8 = 8 * (c & 1);
                    u32x4 w; w.x = cvtpk(ps[b8 + 0], ps[b8 + 1]); w.y = cvtpk(ps[b8 + 2], ps[b8 + 3]); w.z = cvtpk(ps[b8 + 4], ps[b8 + 5]); w.w = cvtpk(ps[b8 + 6], ps[b8 + 7]);
                    const bf16x8 pb = __builtin_bit_cast(bf16x8, w);
                    const LAS unsigned char* va = vb + (16 * c + 4 * hi + ((lane & 15) >> 2)) * (VP * 2) + (16 * ((lane >> 4) & 1) + 4 * (lane & 3)) * 2;
                    const s16x4 x0 = __builtin_amdgcn_ds_read_tr16_b64_v4i16((LAS s16x4*)(va)), x1 = __builtin_amdgcn_ds_read_tr16_b64_v4i16((LAS s16x4*)(va + 8 * VP * 2));
                    const s16x4 y0 = __builtin_amdgcn_ds_read_tr16_b64_v4i16((LAS s16x4*)(va + 64)), y1 = __builtin_amdgcn_ds_read_tr16_b64_v4i16((LAS s16x4*)(va + 8 * VP * 2 + 64));
                    const bf16x8 fa = {x0[0], x0[1], x0[2], x0[3], x1[0], x1[1], x1[2], x1[3]}, fb = {y0[0], y0[1], y0[2], y0[3], y1[0], y1[1], y1[2], y1[3]};
                    o0 = __builtin_amdgcn_mfma_f32_32x32x16_bf16(fa, pb, o0, 0, 0, 0);
                    o1 = __builtin_amdgcn_mfma_f32_32x32x16_bf16(fb, pb, o1, 0, 0, 0);
                }
            }
        }
        }
    }
#undef ATT_ISSUE
    const float ltot = lrun + __shfl_xor(lrun, 32);
    const float inv = 1.0f / ltot;
    bf16_t* yrow = Yp + (size_t)qrow * DM;
    float ssy = 0.f;
#pragma unroll
    for (int rg = 0; rg < 4; ++rg) {
        const f32x4 a = {o0[4 * rg] * inv, o0[4 * rg + 1] * inv, o0[4 * rg + 2] * inv, o0[4 * rg + 3] * inv};
        const f32x4 b = {o1[4 * rg] * inv, o1[4 * rg + 1] * inv, o1[4 * rg + 2] * inv, o1[4 * rg + 3] * inv};
        *(u32x2*)(yrow + 8 * rg + 4 * hi) = pack4(a);
        *(u32x2*)(yrow + 32 + 8 * rg + 4 * hi) = pack4(b);
        ssy += ((a.x * a.x + a.y * a.y) + (a.z * a.z + a.w * a.w)) + ((b.x * b.x + b.y * b.y) + (b.z * b.z + b.w * b.w));
    }
    ssy += __shfl_xor(ssy, 32);
    if (hi == 0) ssqh[(size_t)qrow * 8] = ssy;
    __builtin_amdgcn_s_setprio(0);
    __syncthreads();
}
}

#define XB_TMO      128
#define XB_XCNT(j)  (256  + 64 * (j))
#define XB_XSUB(j)  (1280 + 64 * (j))
#define XB_XGEN(j)  (2304 + 64 * (j))
#define XB_TOP      3328
#define XB_TOPGEN   3392
#define XCD_BAR_WORDS 3456
#define XB_SPIN_CAP (1u << 18)
__device__ __forceinline__ unsigned xb_ld(unsigned* p)              { return __hip_atomic_load(p, __ATOMIC_RELAXED, __HIP_MEMORY_SCOPE_AGENT); }
__device__ __forceinline__ unsigned xb_add(unsigned* p, unsigned v) { return __hip_atomic_fetch_add(p, v, __ATOMIC_RELAXED, __HIP_MEMORY_SCOPE_AGENT); }
__device__ __forceinline__ unsigned xb_xcc_id() { return (unsigned)__builtin_amdgcn_s_getreg((3 << 11) | 20) & 0xFu; }
#define XB_SPIN(cond, bar) do { unsigned _sp = 0; while (cond) { __builtin_amdgcn_s_sleep(1); \
    if ((++_sp & 255u) == 0u) { if (xb_ld(&(bar)[XB_TMO])) break; if (_sp > XB_SPIN_CAP) { atomicAdd(&(bar)[XB_TMO], 1u); break; } } } } while (0)
struct XcdBarrier { unsigned* bar; unsigned x; volatile LAS unsigned* st; };
__device__ __forceinline__ XcdBarrier xcd_barrier_post(unsigned* bar, volatile LAS unsigned* st) {
    XcdBarrier b; b.bar = bar; b.x = xb_xcc_id(); b.st = st;
    if (threadIdx.x == 0) (void)xb_add(&bar[XB_XCNT(b.x)], 1u);
    return b;
}
__device__ __forceinline__ void xcd_barrier_complete(unsigned* bar, unsigned x, unsigned& nloc, unsigned& nx) {
    const unsigned G = gridDim.x * gridDim.y * gridDim.z;
    unsigned sum, cnt, mine, sp = 0u;
    for (;;) {
        sum = 0u; cnt = 0u; mine = 0u;
#pragma unroll
        for (unsigned j = 0; j < 16; ++j) { const unsigned c = xb_ld(&bar[XB_XCNT(j)]); sum += c; cnt += (c > 0u) ? 1u : 0u; mine = (j == x) ? c : mine; }
        if (sum == G) break;
        __builtin_amdgcn_s_sleep(1);
        if ((++sp & 255u) == 0u) { if (xb_ld(&bar[XB_TMO])) break; if (sp > XB_SPIN_CAP) { atomicAdd(&bar[XB_TMO], 1u); break; } }
    }
    nloc = mine > 0u ? mine : 1u; nx = cnt > 0u ? cnt : 1u;
}
__device__ __forceinline__ void xcd_barrier(const XcdBarrier& b) {
    asm volatile("s_waitcnt vmcnt(0)" ::: "memory");
    __syncthreads();
    if (threadIdx.x == 0) {
        unsigned* bar = b.bar;
        __builtin_amdgcn_s_waitcnt(0);
        unsigned nloc = b.st[0], nx = b.st[1];
        if (nloc == 0u) { xcd_barrier_complete(bar, b.x, nloc, nx); b.st[0] = nloc; b.st[1] = nx; }
        const unsigned old = xb_add(&bar[XB_XSUB(b.x)], 1u);
        const unsigned gen = old / nloc;
        if (old + 1u == (gen + 1u) * nloc) {
            __builtin_amdgcn_fence(__ATOMIC_RELEASE, "agent");
            asm volatile("s_waitcnt vmcnt(0)" ::: "memory");
            const unsigned og = xb_add(&bar[XB_TOP], 1u);
            const unsigned tg = og / nx;
            if (og + 1u == (tg + 1u) * nx) xb_add(&bar[XB_TOPGEN], 1u);
            else XB_SPIN(xb_ld(&bar[XB_TOPGEN]) == tg, bar);
            __builtin_amdgcn_fence(__ATOMIC_ACQUIRE, "agent");
            xb_add(&bar[XB_XGEN(b.x)], 1u);
            asm volatile("s_waitcnt vmcnt(0)" ::: "memory");
        } else {
            XB_SPIN(xb_ld(&bar[XB_XGEN(b.x)]) == gen, bar);
            __builtin_amdgcn_fence(__ATOMIC_ACQUIRE, "agent");
            asm volatile("s_waitcnt vmcnt(0)" ::: "memory");
        }
    }
    __syncthreads();
}

struct Args { const float* in[17]; float* out; unsigned char* ws; };
enum { I_X = 0, I_ATTN_NORM, I_W_IN, I_MLA_Q_NORM, I_W_UQ, I_MLA_KV_NORM, I_W_UKV, I_CONV_W, I_POOL_W, I_POOL_SCALE, I_SWA_SINKS, I_MIX_NORM, I_W_O, I_FFN_NORM, I_W_GATE_UP, I_W_DOWN, I_FINAL_NORM };

__device__ __forceinline__ void tr_item(const float* W, int K, int N, const float* gain, bf16_t* WT, int item, int mode, LAS float* scr, int lane) {
    const int nblk = N / 32, kb = item / nblk, nb = item % nblk, k0 = 64 * kb, n0 = 32 * nb;
    int drow0 = n0;
    if (mode == 1) drow0 = (n0 < DFF) ? ((n0 >> 7) * 256 + (n0 & 127)) : (((n0 - DFF) >> 7) * 256 + 128 + ((n0 - DFF) & 127));
    {
        f32x4 v[8];
#pragma unroll
        for (int i = 0; i < 8; ++i) v[i] = __builtin_nontemporal_load((const f32x4*)(W + (size_t)(k0 + 8 * i + (lane >> 3)) * N + n0 + 4 * (lane & 7)));
#pragma unroll
        for (int i = 0; i < 8; ++i) { LAS float* d = scr + (8 * i + (lane >> 3)) * 33 + 4 * (lane & 7); d[0] = v[i].x; d[1] = v[i].y; d[2] = v[i].z; d[3] = v[i].w; }
    }
    asm volatile("s_waitcnt lgkmcnt(0)" ::: "memory");
    const int c = lane & 7;
    f32x4 g0 = {1.f, 1.f, 1.f, 1.f}, g1 = g0;
    if (gain) { g0 = *(const f32x4*)(gain + k0 + 8 * c); g1 = *(const f32x4*)(gain + k0 + 8 * c + 4); }
#pragma unroll
    for (int j = 0; j < 4; ++j) { const int n = (lane >> 3) + 8 * j; const LAS float* sp = scr + (8 * c) * 33 + n;
        u32x4 o; o.x = cvtpk(sp[0 * 33] * g0.x, sp[1 * 33] * g0.y); o.y = cvtpk(sp[2 * 33] * g0.z, sp[3 * 33] * g0.w); o.z = cvtpk(sp[4 * 33] * g1.x, sp[5 * 33] * g1.y); o.w = cvtpk(sp[6 * 33] * g1.z, sp[7 * 33] * g1.w);
        *(u32x4*)(WT + (size_t)(drow0 + n) * K + k0 + 8 * c) = o; }
    asm volatile("s_waitcnt lgkmcnt(0)" ::: "memory");
}

__global__ void __launch_bounds__(512, 2) fwd_kernel(Args a) {
    extern __shared__ __attribute__((aligned(16))) unsigned char lds_raw[];
    LAS unsigned char* lds = (LAS unsigned char*)lds_raw;
    cg::grid_group grid = cg::this_grid();
    const int G = gridDim.x, bx = blockIdx.x;
    const int vcu = (G % 8 == 0) ? (bx % 8) * (G / 8) + bx / 8 : bx;
    const int NGW = G * 8;
#define PHASE_IDS const int tid = opaque_tid(), lane = tid & 63, wave = __builtin_amdgcn_readfirstlane(tid >> 6), gw = bx * 8 + wave; (void)tid; (void)lane; (void)gw
    unsigned char* ws = a.ws;
    float* cosT = (float*)(ws + WS_COS); float* sinT = (float*)(ws + WS_SIN);
    float* RQ = (float*)(ws + WS_RQ); float* RKV = (float*)(ws + WS_RKV);
    float* SSQA = (float*)(ws + WS_SSQA); float* SSQB = (float*)(ws + WS_SSQB); float* SSQH = (float*)(ws + 56 * MiB);
    bf16_t* KR = (bf16_t*)(ws + WS_KR); bf16_t* XB = (bf16_t*)(ws + WS_XB); bf16_t* YB = (bf16_t*)(ws + WS_YB);
    bf16_t* PROJ = (bf16_t*)(ws + WS_PROJ); bf16_t* QM = (bf16_t*)(ws + WS_QM); bf16_t* KV = (bf16_t*)(ws + WS_KV); bf16_t* ACT = (bf16_t*)(ws + WS_ACT);
    float* OUT = a.out;
    unsigned* BARW = (unsigned*)ws;
    volatile LAS unsigned* BST = (volatile LAS unsigned*)(lds + 131072 + 64);
    if (threadIdx.x < 2) BST[threadIdx.x] = 0u;
    {
        constexpr unsigned XB_MAGIC = 0x600DF1A6u;
        if (bx == 0) {
            const int t = threadIdx.x;
            if (t < 51) { const int w = t < 16 ? XB_XCNT(t) : t < 32 ? XB_XSUB(t - 16) : t < 48 ? XB_XGEN(t - 32) : t == 48 ? XB_TMO : t == 49 ? XB_TOP : XB_TOPGEN;
                __hip_atomic_store(&BARW[w], 0u, __ATOMIC_RELAXED, __HIP_MEMORY_SCOPE_AGENT); }
            asm volatile("s_waitcnt vmcnt(0)" ::: "memory");
            __syncthreads();
            if (t == 0) { __hip_atomic_store(&BARW[64], XB_MAGIC, __ATOMIC_RELAXED, __HIP_MEMORY_SCOPE_AGENT); asm volatile("s_waitcnt vmcnt(0)" ::: "memory"); }
        }
        __syncthreads();
    }
#define GRID_BAR() do { XcdBarrier xb_; xb_.bar = (unsigned*)a.ws; xb_.x = xb_xcc_id(); xb_.st = (volatile LAS unsigned*)(lds + 131072 + 64); xcd_barrier(xb_); } while (0)

    if (PH(0)) {
        PHASE_IDS;
        LAS float* scr = (LAS float*)(lds + wave * 16384);
        constexpr int I_IN = 16 * 61, I_UQ = 4 * 12, I_UKV = 2 * 16, I_O = 16 * 32, I_GU = 16 * 176, I_D = 44 * 32, I_L = I_IN + I_UQ + I_UKV + I_O + I_GU + I_D;
        for (int it = gw; it < 2 * I_L; it += NGW) {
            const int l = it / I_L; int r = it % I_L;
            unsigned char* wl = ws + WS_W + (size_t)l * W_LAYER;
            if (r < I_IN) { tr_item(a.in[I_W_IN] + (size_t)l * DM * DIN, DM, DIN, a.in[I_ATTN_NORM] + l * DM, (bf16_t*)(wl + WO_IN), r, 0, scr, lane); continue; } r -= I_IN;
            if (r < I_UQ) { tr_item(a.in[I_W_UQ] + (size_t)l * 256 * 384, 256, 384, a.in[I_MLA_Q_NORM] + l * 256, (bf16_t*)(wl + WO_UQ), r, 0, scr, lane); continue; } r -= I_UQ;
            if (r < I_UKV) { tr_item(a.in[I_W_UKV] + (size_t)l * 128 * 512, 128, 512, a.in[I_MLA_KV_NORM] + l * 128, (bf16_t*)(wl + WO_UKV), r, 0, scr, lane); continue; } r -= I_UKV;
            if (r < I_O) { tr_item(a.in[I_W_O] + (size_t)l * DM * DM, DM, DM, a.in[I_MIX_NORM] + l * DM, (bf16_t*)(wl + WO_O), r, 0, scr, lane); continue; } r -= I_O;
            if (r < I_GU) { tr_item(a.in[I_W_GATE_UP] + (size_t)l * DM * 2 * DFF, DM, 2 * DFF, a.in[I_FFN_NORM] + l * DM, (bf16_t*)(wl + WO_GU), r, 1, scr, lane); continue; } r -= I_GU;
            tr_item(a.in[I_W_DOWN] + (size_t)l * DFF * DM, DFF, DM, nullptr, (bf16_t*)(wl + WO_D), r, 0, scr, lane);
        }
        {
            const int gt = bx * 512 + tid, NT = G * 512;
            const u32x4 z = {0u, 0u, 0u, 0u};
            for (int l = 0; l < 2; ++l) {
                unsigned char* wl = ws + WS_W + (size_t)l * W_LAYER;
                u32x4* p1 = (u32x4*)(wl + WO_IN + (size_t)DIN * DM * 2);
                for (int i = gt; i < (DINP - DIN) * DM * 2 / 16; i += NT) p1[i] = z;
                u32x4* p2 = (u32x4*)(wl + WO_UQ + (size_t)384 * 256 * 2);
                for (int i = gt; i < 128 * 256 * 2 / 16; i += NT) p2[i] = z;
            }
            for (int i = gt; i < 2 * 16384; i += NT) { const int l = i >> 14, idx = i & 16383, g = idx >> 12, c = (idx >> 6) & 63, d = idx & 63;
                ((bf16_t*)(ws + 57 * MiB))[(size_t)l * 18432 + (g * 64 + d) * 72 + c] = (bf16_t)(cvtpk(a.in[I_POOL_W][i], 0.f) & 0xffffu); }
            for (int i = gt; i < SEQ * 16; i += NT) {
                const int pos = i >> 4, j = i & 15;
                const float inv = 1.0f / powf(10000.0f, (float)(2 * j) / 32.0f);
                const float ang = (float)pos * inv;
                cosT[i] = cosf(ang); sinT[i] = sinf(ang);
            }
        }
        const float* X = a.in[I_X];
        for (int r16 = (vcu * 8 + wave) * 16; r16 < T_TOK; r16 += NGW * 16)
        for (int r4 = r16; r4 < r16 + 16; r4 += 8) {
            f32x4 v[8][4];
#pragma unroll
            for (int k = 0; k < 8; ++k)
#pragma unroll
                for (int j = 0; j < 4; ++j) v[k][j] = __builtin_nontemporal_load((const f32x4*)(X + (size_t)(r4 + k) * DM) + lane + 64 * j);
            float ss[8];
#pragma unroll
            for (int k = 0; k < 8; ++k) { ss[k] = 0.f;
#pragma unroll
                for (int j = 0; j < 4; ++j) { const f32x4 w = v[k][j]; ss[k] += (w.x * w.x + w.y * w.y) + (w.z * w.z + w.w * w.w); ((u32x2*)(XB + (size_t)(r4 + k) * DM) + lane)[64 * j] = pack4(w); } }
#pragma unroll
            for (int o = 1; o < 64; o <<= 1) {
#pragma unroll
                for (int k = 0; k < 8; ++k) ss[k] += __shfl_xor(ss[k], o); }
#pragma unroll
            for (int k = 0; k < 8; ++k) if (lane < 16) SSQB[(size_t)(r4 + k) * 16 + lane] = (lane == 0) ? ss[k] : 0.f;
        }
    }
    if (bx != 0 && threadIdx.x == 0) { unsigned sp = 0; while (xb_ld(&BARW[64]) != 0x600DF1A6u) { __builtin_amdgcn_s_sleep(1); if (++sp > (1u << 22)) break; } }
    __syncthreads();
    (void)xcd_barrier_post(BARW, BST);
    if (a.ws == nullptr) grid.sync();
    GRID_BAR();

#pragma unroll 1
    for (int l = 0; l < 2; ++l) {
        unsigned char* wl = ws + WS_W + (size_t)l * W_LAYER;
        const bf16_t* Win_t = (const bf16_t*)(wl + WO_IN); const bf16_t* Wuq_t = (const bf16_t*)(wl + WO_UQ); const bf16_t* Wukv_t = (const bf16_t*)(wl + WO_UKV);
        const bf16_t* Wo_t = (const bf16_t*)(wl + WO_O); const bf16_t* Wgu_t = (const bf16_t*)(wl + WO_GU); const bf16_t* Wd_t = (const bf16_t*)(wl + WO_D);

        if (PH(1)) {
            pg8::Gemm g{XB, Win_t, T_TOK, DINP, DM, DM}; pg8::StaticOrder S; S.init(T_TOK, DINP, G, bx);
            pg8::EpiScaleBf16<0> E{PROJ, DINP, SSQB, RQ, RKV};
            pg8::gemm_phase<pg8::EpiScaleBf16<0>, true>(lds, g, S, E);
        }
        GRID_BAR();

        if (PH(2)) {
            PHASE_IDS;
            {
                const u32x4* img = (const u32x4*)(ws + 57 * MiB) + (size_t)l * 2304;
                for (int i = tid; i < 2304; i += 512) ((LAS u32x4*)lds)[i] = img[i];
            }
            __syncthreads();
            const float* conv_w = a.in[I_CONV_W] + (size_t)l * 3 * 256;
            const float* pscale = a.in[I_POOL_SCALE] + (size_t)l * 256;
#pragma unroll 1
            for (int tile = vcu * 8 + wave; tile < T_TOK / 16; tile += NGW) {
                const int r0 = tile * 16;
                {
                    int ln = lane; asm volatile("" : "+v"(ln));
                    const int t = ln & 15, kq = ln >> 4, row = r0 + t, pos = row & (SEQ - 1);
                    const bf16_t* up = PROJ + (size_t)row * DINP + OFF_UP + 8 * kq;
                    f32x4 acc[4][4]; float ss = 0.f;
#pragma unroll
                    for (int g = 0; g < 4; ++g) {
                        const int w = 2 << g;
                        const float inv = 1.0f / (float)((pos + 1 < w) ? pos + 1 : w);
                        bf16x8 pf[2];
#pragma unroll
                        for (int ks = 0; ks < 2; ++ks) {
                            const bf16_t* p = up + 64 * g + 32 * ks;
                            const u32x4 v0 = *(const u32x4*)p;
                            float sm[8] = {bf_lo(v0.x), bf_hi(v0.x), bf_lo(v0.y), bf_hi(v0.y), bf_lo(v0.z), bf_hi(v0.z), bf_lo(v0.w), bf_hi(v0.w)};
#pragma unroll
                            for (int j = 1; j < w; ++j) {
                                const int jj = (pos >= j) ? j : 0;
                                u32x4 v = *(const u32x4*)(p - (size_t)jj * DINP);
                                const unsigned msk = (pos >= j) ? 0xffffffffu : 0u;
                                v.x &= msk; v.y &= msk; v.z &= msk; v.w &= msk;
                                sm[0] += bf_lo(v.x); sm[1] += bf_hi(v.x); sm[2] += bf_lo(v.y); sm[3] += bf_hi(v.y); sm[4] += bf_lo(v.z); sm[5] += bf_hi(v.z); sm[6] += bf_lo(v.w); sm[7] += bf_hi(v.w);
                            }
                            u32x4 pk;
                            pk.x = cvtpk(sm[0] * inv - bf_lo(v0.x), sm[1] * inv - bf_hi(v0.x)); pk.y = cvtpk(sm[2] * inv - bf_lo(v0.y), sm[3] * inv - bf_hi(v0.y));
                            pk.z = cvtpk(sm[4] * inv - bf_lo(v0.z), sm[5] * inv - bf_hi(v0.z)); pk.w = cvtpk(sm[6] * inv - bf_lo(v0.w), sm[7] * inv - bf_hi(v0.w));
                            pf[ks] = __builtin_bit_cast(bf16x8, pk);
                            asm volatile("" ::: "memory");
                        }
#pragma unroll
                        for (int nb = 0; nb < 4; ++nb) {
                            f32x4 c = {0.f, 0.f, 0.f, 0.f};
#pragma unroll
                            for (int ks = 0; ks < 2; ++ks) {
                                const bf16x8 wf = *(const LAS bf16x8*)(lds + ((g * 64 + 16 * nb + t) * 72 + 32 * ks + 8 * kq) * 2);
                                c = __builtin_amdgcn_mfma_f32_16x16x32_bf16(wf, pf[ks], c, 0, 0, 0);
                            }
                            c = c * *(const f32x4*)(pscale + 64 * g + 16 * nb + 4 * kq);
                            acc[g][nb] = c; ss += (c.x * c.x + c.y * c.y) + (c.z * c.z + c.w * c.w);
                        }
                    }
                    ss += __shfl_xor(ss, 16); ss += __shfl_xor(ss, 32);
                    const float rs = rsqrtf(ss * (1.0f / 256.0f) + RMS_EPS);
                    bf16_t* yo = YB + (size_t)row * DM + 512 + 4 * kq;
#pragma unroll
                    for (int g = 0; g < 4; ++g)
#pragma unroll
                        for (int nb = 0; nb < 4; ++nb) *(u32x2*)(yo + 64 * g + 16 * nb) = pack4(acc[g][nb] * rs);
                    const bf16_t* kr = PROJ + (size_t)row * DINP + OFF_KR + 4 * kq;
                    const f32x4 x1 = unpack4(*(const u32x2*)kr), x2 = unpack4(*(const u32x2*)(kr + 16));
                    const f32x4 cs = *(const f32x4*)(cosT + pos * 16 + 4 * kq), sn = *(const f32x4*)(sinT + pos * 16 + 4 * kq);
                    *(u32x2*)(KR + (size_t)row * 32 + 4 * kq) = pack4(x1 * cs - x2 * sn);
                    *(u32x2*)(KR + (size_t)row * 32 + 16 + 4 * kq) = pack4(x1 * sn + x2 * cs);
                }
#pragma unroll 1
                for (int ps = 0; ps < 2; ++ps) {
                    int ln = lane; asm volatile("" : "+v"(ln) :: "memory");
                    const int rsub = ln >> 3, c8 = ln & 7, row = r0 + 8 * ps + rsub, pos = row & (SEQ - 1);
                    const bf16_t* pr = PROJ + (size_t)row * DINP + 8 * c8;
                    float sy = 0.f;
                    float y[4][8];
#pragma unroll
                    for (int i = 0; i < 4; ++i) {
                        const u32x4 gb = *(const u32x4*)(pr + OFF_GB + 64 * i);
                        const u32x4 gc0 = *(const u32x4*)(pr + OFF_GC + 64 * i), uc0 = *(const u32x4*)(pr + OFF_UC + 64 * i);
                        u32x4 gc1 = {0u, 0u, 0u, 0u}, uc1 = gc1, gc2 = gc1, uc2 = gc1;
                        if (pos >= 1) { gc1 = *(const u32x4*)(pr - DINP + OFF_GC + 64 * i); uc1 = *(const u32x4*)(pr - DINP + OFF_UC + 64 * i); }
                        if (pos >= 2) { gc2 = *(const u32x4*)(pr - 2 * DINP + OFF_GC + 64 * i); uc2 = *(const u32x4*)(pr - 2 * DINP + OFF_UC + 64 * i); }
                        const float* cw = conv_w + 64 * i + 8 * c8;
                        const f32x4 wa0 = *(const f32x4*)(cw), wa1 = *(const f32x4*)(cw + 4), wb0 = *(const f32x4*)(cw + 256), wb1 = *(const f32x4*)(cw + 260), wc0 = *(const f32x4*)(cw + 512), wc1 = *(const f32x4*)(cw + 516);
                        const unsigned gbw[4] = {gb.x, gb.y, gb.z, gb.w}, g0w[4] = {gc0.x, gc0.y, gc0.z, gc0.w}, u0w[4] = {uc0.x, uc0.y, uc0.z, uc0.w};
                        const unsigned g1w[4] = {gc1.x, gc1.y, gc1.z, gc1.w}, u1w[4] = {uc1.x, uc1.y, uc1.z, uc1.w}, g2w[4] = {gc2.x, gc2.y, gc2.z, gc2.w}, u2w[4] = {uc2.x, uc2.y, uc2.z, uc2.w};
                        const float wA[8] = {wa0.x, wa0.y, wa0.z, wa0.w, wa1.x, wa1.y, wa1.z, wa1.w}, wB[8] = {wb0.x, wb0.y, wb0.z, wb0.w, wb1.x, wb1.y, wb1.z, wb1.w}, wC[8] = {wc0.x, wc0.y, wc0.z, wc0.w, wc1.x, wc1.y, wc1.z, wc1.w};
#pragma unroll
                        for (int e = 0; e < 4; ++e) {
                            const float zl2 = bf_lo(g2w[e]) * bf_lo(u2w[e]), zh2 = bf_hi(g2w[e]) * bf_hi(u2w[e]);
                            const float zl1 = bf_lo(g1w[e]) * bf_lo(u1w[e]), zh1 = bf_hi(g1w[e]) * bf_hi(u1w[e]);
                            const float zl0 = bf_lo(g0w[e]) * bf_lo(u0w[e]), zh0 = bf_hi(g0w[e]) * bf_hi(u0w[e]);
                            const float yl = bf_lo(gbw[e]) * (wA[2 * e] * zl2 + wB[2 * e] * zl1 + wC[2 * e] * zl0);
                            const float yh = bf_hi(gbw[e]) * (wA[2 * e + 1] * zh2 + wB[2 * e + 1] * zh1 + wC[2 * e + 1] * zh0);
                            y[i][2 * e] = yl; y[i][2 * e + 1] = yh; sy += yl * yl + yh * yh;
                        }
                        if (i & 1) asm volatile("" ::: "memory");
                    }
#pragma unroll
                    for (int o = 1; o < 8; o <<= 1) sy += __shfl_xor(sy, o);
                    const float rs = rsqrtf(sy * (1.0f / 256.0f) + RMS_EPS);
#pragma unroll
                    for (int i = 0; i < 4; ++i) { u32x4 w; w.x = cvtpk(y[i][0] * rs, y[i][1] * rs); w.y = cvtpk(y[i][2] * rs, y[i][3] * rs); w.z = cvtpk(y[i][4] * rs, y[i][5] * rs); w.w = cvtpk(y[i][6] * rs, y[i][7] * rs);
                        *(u32x4*)(YB + (size_t)row * DM + 256 + 64 * i + 8 * c8) = w; }
                }
            }
            __syncthreads();
        }
        if (PH(3)) {
            const float* sinks = a.in[I_SWA_SINKS] + l * 4;
            for (int it0 = vcu; it0 < 512; it0 += G) {
                int it = it0;
                if (G == 256) { const int u = (vcu & 31) * 2 + (it0 >> 8); it = ((vcu >> 5) * 4 + (u >> 4)) * 16 + (u & 15); }
                const int bh = it >> 4, qb = it & 15, b = bh >> 2, hq = bh & 3, kvh = hq >> 1;
                const bf16_t* base = PROJ + (size_t)b * SEQ * DINP;
                const float slope = exp2f(-8.0f * (float)(hq + 1) / 4.0f);
                att::unit<true>(lds, base + OFF_QSW + hq * 64, DINP, base + OFF_KSW + kvh * 64, DINP, nullptr, base + OFF_VSW + kvh * 64, DINP,
                                YB + (size_t)b * SEQ * DM + 768 + hq * 64, SSQH + (size_t)b * SEQ * 8 + 4 + hq, qb * 256, 0.125f * LOG2E, slope * LOG2E, sinks[hq] * LOG2E);
            }
        }

        if (PH(4)) {
            pg8::Gemm g{PROJ + OFF_CQ, Wuq_t, T_TOK, 512, 256, DINP}; pg8::StaticOrder S; S.init(T_TOK, 512, G, bx);
            pg8::EpiQRope E{QM, RQ, cosT, sinT};
            pg8::gemm_phase<pg8::EpiQRope, true>(lds, g, S, E);
        }
        if (PH(5)) {
            pg8::Gemm g{PROJ + OFF_CKV, Wukv_t, T_TOK, 512, 128, DINP}; pg8::StaticOrder S; S.init(T_TOK, 512, G, bx);
            pg8::EpiScaleBf16<1> E{KV, 512, RKV, nullptr, nullptr};
            pg8::gemm_phase<pg8::EpiScaleBf16<1>, true>(lds, g, S, E);
        }
        GRID_BAR();

        if (PH(6)) for (int it = vcu; it < 256; it += G) {
            const int bh = it >> 3, s = it & 7, b = bh >> 2, h = bh & 3;
            const float csc = LOG2E * 0.10206207261596577f;
#pragma unroll 1
            for (int k = 0; k < 2; ++k) {
                const int qb = k == 0 ? s : 15 - s;
                att::unit<false>(lds, QM + (size_t)b * SEQ * 512 + h * 96, 512, KV + (size_t)b * SEQ * 512 + h * 128, 512, KR + (size_t)b * SEQ * 32,
                                 KV + (size_t)b * SEQ * 512 + h * 128 + 64, 512, YB + (size_t)b * SEQ * DM + h * 64, SSQH + (size_t)b * SEQ * 8 + h, qb * 256, csc, 0.f, 0.f);
            }
        }
        GRID_BAR();

        if (PH(8)) {
            pg8::Gemm g{YB, Wo_t, T_TOK, DM, DM, DM}; pg8::StaticOrder S; S.init(T_TOK, DM, G, bx);
            pg8::EpiResidT<true> E{XB, SSQA, SSQH};
            pg8::gemm_phase<pg8::EpiResidT<true>, true>(lds, g, S, E);
        }
        GRID_BAR();

        if (PH(9)) {
            pg8::Gemm g{XB, Wgu_t, T_TOK, 2 * DFF, DM, DM}; pg8::StaticOrder S; S.init(T_TOK, 2 * DFF, G, bx);
            pg8::EpiSwiGLU E{ACT, SSQA};
            pg8::gemm_phase<pg8::EpiSwiGLU, true>(lds, g, S, E);
        }
        GRID_BAR();

        if (PH(10)) {
            pg8::Gemm g{ACT, Wd_t, T_TOK, DM, DFF, DFF}; pg8::StaticOrder S; S.init(T_TOK, DM, G, bx);
            pg8::EpiResidT<false> E{XB, SSQB, nullptr};
            pg8::gemm_phase<pg8::EpiResidT<false>, true>(lds, g, S, E);
        }
        GRID_BAR();
    }

    if (bx == 0 && threadIdx.x == 0) __hip_atomic_store(&BARW[64], 0u, __ATOMIC_RELAXED, __HIP_MEMORY_SCOPE_AGENT);
    if (PH(11)) {
        PHASE_IDS;
        const float* fg = a.in[I_FINAL_NORM];
        f32x4 gv[4];
#pragma unroll
        for (int j = 0; j < 4; ++j) gv[j] = ((const f32x4*)fg)[64 * j + lane];
#pragma unroll 1
        for (int r16 = (vcu * 8 + wave) * 16; r16 < T_TOK; r16 += NGW * 16)
#pragma unroll 1
        for (int r4 = r16; r4 < r16 + 16; r4 += 4) {
            u32x2 v[4][4]; float rs[4];
#pragma unroll
            for (int k = 0; k < 4; ++k) {
#pragma unroll
                for (int j = 0; j < 4; ++j) v[k][j] = ((const u32x2*)(XB + (size_t)(r4 + k) * DM) + lane)[64 * j];
                rs[k] = pg8::rstd_from_partials(SSQB, r4 + k);
            }
#pragma unroll
            for (int k = 0; k < 4; ++k)
#pragma unroll
                for (int j = 0; j < 4; ++j) __builtin_nontemporal_store(unpack4(v[k][j]) * rs[k] * gv[j], (f32x4*)(OUT + (size_t)(r4 + k) * DM) + lane + 64 * j);
        }
    }
}

extern "C" void kernel_launch(void* const* d_in, const int* in_sizes, int n_in, void* d_out, int out_size, void* d_ws, size_t ws_size, hipStream_t stream) {
    static int grid = 0;
    if (grid == 0) {
        if (n_in != 17 || out_size != T_TOK * DM || ws_size < WS_END) { fprintf(stderr, "kernel_launch: unexpected problem shape (n_in %d out %d ws %zu)\n", n_in, out_size, ws_size); grid = -1; return; }
        int dev = 0, cus = 0, per_cu = 0;
        hipGetDevice(&dev);
        hipDeviceGetAttribute(&cus, hipDeviceAttributeMultiprocessorCount, dev);
        hipFuncSetAttribute((const void*)fwd_kernel, hipFuncAttributeMaxDynamicSharedMemorySize, LDS_BYTES);
        hipOccupancyMaxActiveBlocksPerMultiprocessor(&per_cu, (const void*)fwd_kernel, 512, LDS_BYTES);
        if (per_cu < 1) { fprintf(stderr, "kernel_launch: occupancy query says %d blocks per CU\n", per_cu); per_cu = 1; }
        (void)hipGetLastError();
        grid = cus * 1;
        if ((T_TOK / 256) * (DM / 256) > 3 * grid) { fprintf(stderr, "kernel_launch: %d CUs are too few for the per-phase factor tables of this kernel (needs >= 171)\n", cus); grid = -1; return; }
    }
    if (grid < 0) return;
    Args a{};
    for (int i = 0; i < 17; ++i) a.in[i] = (const float*)d_in[i];
    a.out = (float*)d_out; a.ws = (unsigned char*)d_ws;
    void* args[] = {&a};
    hipError_t e = hipLaunchCooperativeKernel((const void*)fwd_kernel, dim3(grid), dim3(512), args, LDS_BYTES, stream);
    if (e != hipSuccess) fprintf(stderr, "cooperative launch failed: %s (grid %d)\n", hipGetErrorString(e), grid);
}
```
